# Optimizing an MI355X kernel written in HIP

```python
import math
import jax
import jax.numpy as jnp
from jax import lax
import numpy as np

D_MODEL = 1024
BATCH = 32
SEQ = 256
DEPTH = 4
DEC_BATCH = 4
DEC_SEQ = 2048
PAST_LEN = 512

GRID_W = 64
N_MIXERS = 4
HEAD_DIM = 64
ROPE_THETA = 10000.0
Q_BLOCK = 128
WINDOW = 128
EPS = 1e-6
NEG_INF = -1e30
A_HEADS = D_MODEL // (2 * HEAD_DIM)
A_VDIM = 2 * HEAD_DIM
GQA_HEADS = D_MODEL // HEAD_DIM
GQA_KV_HEADS = GQA_HEADS // 4
GQA_GROUP = GQA_HEADS // GQA_KV_HEADS
D_KDIM = 128
D_HEADS = D_MODEL // D_KDIM
D_VDIM = D_MODEL // D_HEADS
D_FDIM = D_HEADS * D_KDIM
CHUNK = 64
D_FF = -(-8 * D_MODEL // (3 * 256)) * 256
N_LAYERS_A = (DEPTH + 3) // 4
N_LAYERS_B = (DEPTH + 2) // 4
N_LAYERS_C = (DEPTH + 1) // 4
N_LAYERS_D = DEPTH // 4

kernel_name = 'hybrid_diffusion_prefix_trunk_step'


def rms_norm(x, gain):
    xf = x.astype(jnp.float32)
    y = xf * lax.rsqrt(jnp.mean(xf * xf, axis=-1, keepdims=True) + EPS)
    return (y * gain.astype(jnp.float32)).astype(x.dtype)


def modulate(h, shift, scale):
    return h * (1 + scale[:, None]) + shift[:, None]


def axial_rope_tables(n_tokens):
    rows = n_tokens // GRID_W
    row = jnp.repeat(jnp.arange(rows, dtype=jnp.float32), GRID_W)
    col = jnp.tile(jnp.arange(GRID_W, dtype=jnp.float32), rows)
    axis_dim = HEAD_DIM // 2
    inv_freq = ROPE_THETA ** (-jnp.arange(0, axis_dim, 2, dtype=jnp.float32) / axis_dim)
    ang = jnp.stack([row[:, None] * inv_freq, col[:, None] * inv_freq], axis=1)
    return jnp.cos(ang), jnp.sin(ang)


def apply_rope(x, cos, sin):
    b, t, h, dh = x.shape
    xr = x.reshape(b, t, h, 2, 2, dh // 4)
    x1, x2 = xr[..., 0, :], xr[..., 1, :]
    cs = cos[None, :, None].astype(x.dtype)
    sn = sin[None, :, None].astype(x.dtype)
    out = jnp.stack([x1 * cs - x2 * sn, x2 * cs + x1 * sn], axis=-2)
    return out.reshape(b, t, h, dh)


def sweep_query_blocks(fn, q):
    b, t = q.shape[:2]
    nb = t // Q_BLOCK
    qb = jnp.moveaxis(q.reshape((b, nb, Q_BLOCK) + q.shape[2:]), 1, 0)
    out = lax.map(lambda a: fn(a[0], a[1]), (qb, jnp.arange(nb)))
    return jnp.moveaxis(out, 0, 1).reshape((b, t) + out.shape[3:])


def gqa_scores(qb, k):
    return jnp.einsum('bqgrd,bsgd->bgrqs', qb, k).astype(jnp.float32) * (HEAD_DIM ** -0.5)


def gqa_values(p, v):
    return jnp.einsum('bgrqs,bsgd->bqgrd', p.astype(v.dtype), v)


def softmax_with_sink(s, sink):
    sk = jnp.broadcast_to(sink[None, :, :, None, None], s.shape[:-1] + (1,))
    return jax.nn.softmax(jnp.concatenate([sk, s], axis=-1), axis=-1)[..., 1:]


def dense_gqa(q, k, v, sink):
    def block(qb, _):
        s = gqa_scores(qb, k)
        p = jax.nn.softmax(s, axis=-1) if sink is None else softmax_with_sink(s, sink)
        return gqa_values(p, v)
    return sweep_query_blocks(block, q)


def project_gqa(h, w_qkv, q_gain, k_gain, rope):
    b, t, _ = h.shape
    q, k, v = jnp.split(h @ w_qkv, [GQA_HEADS * HEAD_DIM, (GQA_HEADS + GQA_KV_HEADS) * HEAD_DIM], axis=-1)
    q = rms_norm(q.reshape(b, t, GQA_HEADS, HEAD_DIM), q_gain)
    k = rms_norm(k.reshape(b, t, GQA_KV_HEADS, HEAD_DIM), k_gain)
    v = v.reshape(b, t, GQA_KV_HEADS, HEAD_DIM)
    if rope is not None:
        q = apply_rope(q, *rope)
        k = apply_rope(k, *rope)
    return q.reshape(b, t, GQA_KV_HEADS, GQA_GROUP, HEAD_DIM), k, v


def mixer_diff_attn(h, w_qkv, w_o, q_gain, k_gain, sub_gain, lam, lam_init, rope, ctx_k, ctx_v):
    b, t, _ = h.shape
    q, k, v = jnp.split(h @ w_qkv, [D_MODEL, 2 * D_MODEL], axis=-1)
    q = rms_norm(q.reshape(b, t, 2 * A_HEADS, HEAD_DIM), q_gain)
    k = rms_norm(k.reshape(b, t, 2 * A_HEADS, HEAD_DIM), k_gain)
    v = v.reshape(b, t, A_HEADS, A_VDIM)
    if rope is not None:
        q = apply_rope(q, *rope)
        k = apply_rope(k, *rope)
    keys, vals = (k, v) if ctx_k is None else (jnp.concatenate([ctx_k, k], axis=1), jnp.concatenate([ctx_v, v], axis=1))
    keys = keys.reshape(b, keys.shape[1], A_HEADS, 2, HEAD_DIM)
    qh = q.reshape(b, t, A_HEADS, 2, HEAD_DIM)

    def block(qb, _):
        s = jnp.einsum('bqhmd,bkhmd->bhmqk', qb, keys).astype(jnp.float32) * (HEAD_DIM ** -0.5)
        p = jax.nn.softmax(s, axis=-1)
        a = p[:, :, 0] - lam * p[:, :, 1]
        return jnp.einsum('bhqk,bkhe->bqhe', a.astype(vals.dtype), vals)

    o = sweep_query_blocks(block, qh)
    o = rms_norm(o, sub_gain) * (1.0 - lam_init)
    return o.reshape(b, t, D_MODEL) @ w_o, k, v


def mixer_window_sink(h, w_qkv, w_o, q_gain, k_gain, sink, rope, ctx_k, ctx_v):
    b, t, _ = h.shape
    q, k, v = project_gqa(h, w_qkv, q_gain, k_gain, rope)
    sink = sink.astype(jnp.float32).reshape(GQA_KV_HEADS, GQA_GROUP)
    if ctx_k is None:
        o = dense_gqa(q, k, v, sink)
    else:
        n_ctx = ctx_k.shape[1]
        pad = ((0, 0), (Q_BLOCK, Q_BLOCK), (0, 0), (0, 0))
        kp, vp = jnp.pad(k, pad), jnp.pad(v, pad)
        offs = jnp.arange(3 * Q_BLOCK) - Q_BLOCK
        qi = jnp.arange(Q_BLOCK)

        def block(qb, j):
            kb = lax.dynamic_slice_in_dim(kp, j * Q_BLOCK, 3 * Q_BLOCK, axis=1)
            vb = lax.dynamic_slice_in_dim(vp, j * Q_BLOCK, 3 * Q_BLOCK, axis=1)
            qpos = j * Q_BLOCK + qi
            kpos = j * Q_BLOCK + offs
            valid = (jnp.abs(qpos[:, None] - kpos[None, :]) <= WINDOW) & ((kpos >= 0) & (kpos < t))[None, :]
            s_band = jnp.where(valid, gqa_scores(qb, kb), NEG_INF)
            s_ctx = gqa_scores(qb, ctx_k)
            p = softmax_with_sink(jnp.concatenate([s_ctx, s_band], axis=-1), sink)
            return gqa_values(p[..., :n_ctx], ctx_v) + gqa_values(p[..., n_ctx:], vb)

        o = sweep_query_blocks(block, q)
    return o.reshape(b, t, D_MODEL) @ w_o, k, v


def mixer_axial_gqa(h, w_qkv, w_o, q_gain, k_gain, rope, ctx_k, ctx_v):
    b, t, _ = h.shape
    q, k, v = project_gqa(h, w_qkv, q_gain, k_gain, rope)
    keys, vals = (k, v) if ctx_k is None else (jnp.concatenate([ctx_k, k], axis=1), jnp.concatenate([ctx_v, v], axis=1))
    o = dense_gqa(q, keys, vals, None)
    return o.reshape(b, t, D_MODEL) @ w_o, k, v


def chunk_gla(q, k, v, log_f, s0):
    b, t, h, dk = q.shape
    n = t // CHUNK
    rs = lambda a: a.reshape(b, n, CHUNK, h, a.shape[-1]).astype(jnp.float32)
    q, k, v, log_f = rs(q), rs(k), rs(v), rs(log_f)
    cum = jnp.cumsum(log_f, axis=2)
    last = cum[:, :, -1:]
    q_dec = q * jnp.exp(cum)
    k_in = k * jnp.exp(-cum)
    k_out = k * jnp.exp(last - cum)
    mask = jnp.tril(jnp.ones((CHUNK, CHUNK), jnp.float32))
    att = jnp.einsum('bnchk,bnshk->bnhcs', q_dec, k_in) * mask
    o_intra = jnp.einsum('bnhcs,bnshv->bnchv', att, v)
    d_state = jnp.einsum('bnshk,bnshv->bnhkv', k_out, v)
    decay = jnp.exp(last[:, :, 0])

    def step(s, inp):
        dec, ds = inp
        return dec[..., None] * s + ds, s

    s_final, s_prev = lax.scan(step, s0.astype(jnp.float32), (jnp.moveaxis(decay, 1, 0), jnp.moveaxis(d_state, 1, 0)))
    s_prev = jnp.moveaxis(s_prev, 0, 1)
    o_inter = jnp.einsum('bnchk,bnhkv->bnchv', q_dec, s_prev)
    return (o_intra + o_inter).reshape(b, t, h, v.shape[-1]), s_final


def mixer_hgrn2(h, w_in, w_o, g_gain, lb, s0):
    b, t, _ = h.shape
    q, f_fwd, f_bwd, i, g = jnp.split(h @ w_in, [D_FDIM, 2 * D_FDIM, 3 * D_FDIM, 3 * D_FDIM + D_MODEL], axis=-1)
    q = jax.nn.silu(q).reshape(b, t, D_HEADS, D_KDIM)
    v = i.reshape(b, t, D_HEADS, D_VDIM)
    outs, finals = [], []
    for d, f_logit in enumerate((f_fwd, f_bwd)):
        lbd = lb[d].astype(jnp.float32)
        f = lbd + (1.0 - lbd) * jax.nn.sigmoid(f_logit.astype(jnp.float32))
        k = (1.0 - f).reshape(b, t, D_HEADS, D_KDIM)
        log_f = jnp.log(f).reshape(b, t, D_HEADS, D_KDIM)
        qd, vd = q, v
        if d == 1:
            qd, k, vd, log_f = (jnp.flip(a, axis=1) for a in (qd, k, vd, log_f))
        o, s_fin = chunk_gla(qd, k, vd, log_f, s0[:, d])
        if d == 1:
            o = jnp.flip(o, axis=1)
        outs.append(o)
        finals.append(s_fin)
    o = (outs[0] + outs[1]).astype(h.dtype)
    o = rms_norm(o, g_gain) * jax.nn.silu(g.reshape(b, t, D_HEADS, D_VDIM))
    return o.reshape(b, t, D_MODEL) @ w_o, jnp.stack(finals, axis=1)


def swiglu(h, w_gate, w_up, w_down):
    return (jax.nn.silu(h @ w_gate) * (h @ w_up)) @ w_down


def setup_inputs(seed: int = 0) -> dict:
    key = jax.random.key(seed)
    ks = iter(jax.random.split(key, 48))

    def normal(shape, scale):
        return jax.random.normal(next(ks), shape, jnp.float32) * scale

    def gain(shape):
        return 1.0 + normal(shape, 0.05)

    D = D_MODEL
    gqa_in = (GQA_HEADS + 2 * GQA_KV_HEADS) * HEAD_DIM
    return {
        'x_prompt': normal((BATCH, SEQ, D), 1.0),
        'x_sample': normal((DEC_BATCH, DEC_SEQ, D), 1.0),
        'c': normal((DEC_BATCH, D), 1.0),
        'cache_a_k': normal((DEC_BATCH, N_LAYERS_A, PAST_LEN, 2 * A_HEADS, HEAD_DIM), 1.0),
        'cache_a_v': normal((DEC_BATCH, N_LAYERS_A, PAST_LEN, A_HEADS, A_VDIM), 1.0),
        'cache_b_k': normal((DEC_BATCH, N_LAYERS_B, PAST_LEN, GQA_KV_HEADS, HEAD_DIM), 1.0),
        'cache_b_v': normal((DEC_BATCH, N_LAYERS_B, PAST_LEN, GQA_KV_HEADS, HEAD_DIM), 1.0),
        'cache_c_k': normal((DEC_BATCH, N_LAYERS_C, PAST_LEN, GQA_KV_HEADS, HEAD_DIM), 1.0),
        'cache_c_v': normal((DEC_BATCH, N_LAYERS_C, PAST_LEN, GQA_KV_HEADS, HEAD_DIM), 1.0),
        'state_d': normal((DEC_BATCH, N_LAYERS_D, 2, D_HEADS, D_KDIM, D_VDIM), 0.3),
        'c_ctx': normal((D,), 1.0),
        'norm_mix': gain((DEPTH, D)),
        'norm_ffn': gain((DEPTH, D)),
        'w_ada': normal((DEPTH, D, 6 * D), 0.5 * D ** -0.5),
        'b_ada': normal((DEPTH, 6 * D), 0.01),
        'w_ffn_gate': normal((DEPTH, D, D_FF), D ** -0.5),
        'w_ffn_up': normal((DEPTH, D, D_FF), D ** -0.5),
        'w_ffn_down': normal((DEPTH, D_FF, D), D_FF ** -0.5),
        'w_qkv_a': normal((N_LAYERS_A, D, 3 * D), D ** -0.5),
        'w_o_a': normal((N_LAYERS_A, D, D), D ** -0.5),
        'qn_a': gain((N_LAYERS_A, HEAD_DIM)),
        'kn_a': gain((N_LAYERS_A, HEAD_DIM)),
        'subln_a': gain((N_LAYERS_A, A_VDIM)),
        'lam_q1_a': normal((N_LAYERS_A, HEAD_DIM), 0.1),
        'lam_k1_a': normal((N_LAYERS_A, HEAD_DIM), 0.1),
        'lam_q2_a': normal((N_LAYERS_A, HEAD_DIM), 0.1),
        'lam_k2_a': normal((N_LAYERS_A, HEAD_DIM), 0.1),
        'w_qkv_b': normal((N_LAYERS_B, D, gqa_in), D ** -0.5),
        'w_o_b': normal((N_LAYERS_B, D, D), D ** -0.5),
        'qn_b': gain((N_LAYERS_B, HEAD_DIM)),
        'kn_b': gain((N_LAYERS_B, HEAD_DIM)),
        'sink_b': normal((N_LAYERS_B, GQA_HEADS), 0.5),
        'w_qkv_c': normal((N_LAYERS_C, D, gqa_in), D ** -0.5),
        'w_o_c': normal((N_LAYERS_C, D, D), D ** -0.5),
        'qn_c': gain((N_LAYERS_C, HEAD_DIM)),
        'kn_c': gain((N_LAYERS_C, HEAD_DIM)),
        'w_in_d': normal((N_LAYERS_D, D, 3 * D_FDIM + 2 * D), D ** -0.5),
        'w_o_d': normal((N_LAYERS_D, D, D), D ** -0.5),
        'gn_d': gain((N_LAYERS_D, D_VDIM)),
        'lb_logits_d': normal((2, DEPTH, D_FDIM), 0.5),
    }


def reference(x_prompt, x_sample, c, cache_a_k, cache_a_v, cache_b_k, cache_b_v, cache_c_k, cache_c_v,
              state_d, c_ctx, norm_mix, norm_ffn, w_ada, b_ada, w_ffn_gate, w_ffn_up, w_ffn_down,
              w_qkv_a, w_o_a, qn_a, kn_a, subln_a, lam_q1_a, lam_k1_a, lam_q2_a, lam_k2_a,
              w_qkv_b, w_o_b, qn_b, kn_b, sink_b, w_qkv_c, w_o_c, qn_c, kn_c,
              w_in_d, w_o_d, gn_d, lb_logits_d):
    rope = axial_rope_tables(x_sample.shape[1])
    cond_ctx = jax.nn.silu(c_ctx)[None]
    cond_lat = jax.nn.silu(c)
    p_lb = jax.nn.softmax(lb_logits_d.astype(jnp.float32), axis=1)
    lb_all = jnp.cumsum(p_lb, axis=1) - p_lb[:, :1]
    zero_state = jnp.zeros((x_prompt.shape[0], 2, D_HEADS, D_KDIM, D_VDIM), jnp.float32)

    xp, xs = x_prompt, x_sample
    new_a_k, new_a_v, new_b_k, new_b_v, new_c_k, new_c_v, new_d = [], [], [], [], [], [], []
    for li in range(DEPTH):
        kind, j = li % N_MIXERS, li // N_MIXERS
        mod_p = jnp.split(cond_ctx @ w_ada[li] + b_ada[li], 6, axis=-1)
        mod_s = jnp.split(cond_lat @ w_ada[li] + b_ada[li], 6, axis=-1)
        hp = modulate(rms_norm(xp, norm_mix[li]), mod_p[0], mod_p[1])
        hs = modulate(rms_norm(xs, norm_mix[li]), mod_s[0], mod_s[1])
        if kind == 0:
            lam_init = 0.8 - 0.6 * math.exp(-0.3 * li)
            lam = (jnp.exp(jnp.sum(lam_q1_a[j] * lam_k1_a[j])) - jnp.exp(jnp.sum(lam_q2_a[j] * lam_k2_a[j]))
                   + lam_init).astype(jnp.float32)
            op, kc, vc = mixer_diff_attn(hp, w_qkv_a[j], w_o_a[j], qn_a[j], kn_a[j], subln_a[j], lam, lam_init,
                                         None, None, None)
            os_, _, _ = mixer_diff_attn(hs, w_qkv_a[j], w_o_a[j], qn_a[j], kn_a[j], subln_a[j], lam, lam_init,
                                        rope, cache_a_k[:, j], cache_a_v[:, j])
            new_a_k.append(kc)
            new_a_v.append(vc)
        elif kind == 1:
            op, kc, vc = mixer_window_sink(hp, w_qkv_b[j], w_o_b[j], qn_b[j], kn_b[j], sink_b[j], None, None, None)
            os_, _, _ = mixer_window_sink(hs, w_qkv_b[j], w_o_b[j], qn_b[j], kn_b[j], sink_b[j],
                                          rope, cache_b_k[:, j], cache_b_v[:, j])
            new_b_k.append(kc)
            new_b_v.append(vc)
        elif kind == 2:
            op, kc, vc = mixer_axial_gqa(hp, w_qkv_c[j], w_o_c[j], qn_c[j], kn_c[j], None, None, None)
            os_, _, _ = mixer_axial_gqa(hs, w_qkv_c[j], w_o_c[j], qn_c[j], kn_c[j],
                                        rope, cache_c_k[:, j], cache_c_v[:, j])
            new_c_k.append(kc)
            new_c_v.append(vc)
        else:
            op, sc = mixer_hgrn2(hp, w_in_d[j], w_o_d[j], gn_d[j], lb_all[:, li], zero_state)
            os_, _ = mixer_hgrn2(hs, w_in_d[j], w_o_d[j], gn_d[j], lb_all[:, li], state_d[:, j])
            new_d.append(sc)
        xp = xp + mod_p[2][:, None] * op
        xs = xs + mod_s[2][:, None] * os_
        hp = modulate(rms_norm(xp, norm_ffn[li]), mod_p[3], mod_p[4])
        hs = modulate(rms_norm(xs, norm_ffn[li]), mod_s[3], mod_s[4])
        xp = xp + mod_p[5][:, None] * swiglu(hp, w_ffn_gate[li], w_ffn_up[li], w_ffn_down[li])
        xs = xs + mod_s[5][:, None] * swiglu(hs, w_ffn_gate[li], w_ffn_up[li], w_ffn_down[li])

    return (xp, xs, jnp.stack(new_a_k, axis=1), jnp.stack(new_a_v, axis=1), jnp.stack(new_b_k, axis=1),
            jnp.stack(new_b_v, axis=1), jnp.stack(new_c_k, axis=1), jnp.stack(new_c_v, axis=1),
            jnp.stack(new_d, axis=1))
```

```cpp
#include <hip/hip_runtime.h>
#include <hip/hip_cooperative_groups.h>
#include <cstdio>
#include <cstdint>
namespace cg = cooperative_groups;
#define N_LAUNCH_MODE 1
namespace pg8 {
#define PG8_LAS __attribute__((address_space(3)))
typedef unsigned short bf16_t;
typedef short bf16x8 __attribute__((ext_vector_type(8)));
typedef float f32x4 __attribute__((ext_vector_type(4)));
typedef unsigned u32x4 __attribute__((ext_vector_type(4)));
constexpr int BM = 256, BK = 64, HALF = 128, HTB = HALF * BK * 2  , STAGE_BYTES = 8 * HTB, NXCD = 8, WGM = 8;

__host__ __device__ __forceinline__ int lds_byte(int r, int c) { const int st = (r >> 4) * 2 + (c >> 5), rr = r & 15, cc = c & 31, ob = rr * 64 + cc * 2; return st * 1024 + (ob ^ (((ob >> 9) & 1) << 5)); }
__host__ __device__ __forceinline__ void stage_rc(int b, int& R, int& C) { const int st = b / 1024, sb = b % 1024, swz = sb ^ (((sb >> 9) & 1) << 5); R = (st >> 1) * 16 + swz / 64; C = (st & 1) * 32 + (swz % 64) / 2; }
__host__ __device__ __forceinline__ int perm32(int rho) { const int n = rho >> 4, i = rho & 15; return 8 * (i >> 2) + 4 * n + (i & 3); }

struct Unit { int pm, pn, idx; };
struct Gemm { const bf16_t* A; const bf16_t* Bt; int M, N, K; };

struct StaticOrder {
    int nM, nN, nwg, G, c;
    __host__ __device__ void init(int M, int N, int G_, int c_) { nM = M / BM; nN = N / BM; nwg = nM * nN; G = G_; c = c_; }
    __host__ __device__ bool next(int i, Unit& u) const {
        const long L = (long)i * G + c; if (L >= nwg) return false;
        int wgid = (int)L; { const int q = nwg / NXCD, r = nwg % NXCD, xcd = wgid % NXCD, off = wgid / NXCD; wgid = (xcd < r ? xcd * (q + 1) : r * (q + 1) + (xcd - r) * q) + off; }
        const int nig = WGM * nN, gid = wgid / nig, fm = gid * WGM, gsz = (nM - fm) < WGM ? (nM - fm) : WGM;
        u.pm = fm + ((wgid % nig) % gsz); u.pn = (wgid % nig) / gsz; u.idx = i; return true;
    }
    __device__ __forceinline__ void a_ready(const Unit&) const {}
    __device__ __forceinline__ void done(const Unit&) const {}
};
template <class Epi, class Sched, bool ALIGN_EPI = false, bool SP2 = false, int KROT = 0>
__device__ __forceinline__ void gemm_phase(PG8_LAS unsigned char* lds, const Gemm g, const Sched& S, const Epi& E, int wid_s) {
    unsigned msk_o = ~0u; asm volatile("" : "+s"(msk_o)); int tid_l = (int)__builtin_amdgcn_mbcnt_hi(msk_o, __builtin_amdgcn_mbcnt_lo(msk_o, 0u)); tid_l += wid_s * 64;
    int wid_o = wid_s; asm volatile("" : "+s"(wid_o));
    const int tid = tid_l, wid = wid_o, lane = tid & 63, wr = wid >> 2, wc = wid & 3, fr = lane & 15, fq = lane >> 4;
    const int K = g.K, nt = K / BK;
    unsigned voffA[2], voffB[2];
#pragma unroll
    for (int i = 0; i < 2; ++i) { int R, C; stage_rc(tid * 16 + i * 8192, R, C); const int Rb = Epi::PERM ? ((R & ~31) + perm32(R & 31)) : R;
        voffA[i] = (unsigned)(R * K + C) * 2u; voffB[i] = (unsigned)(Rb * K + C) * 2u; }
    const size_t kstep = (size_t)(BK * 2);
    const size_t hstep = (size_t)HALF * K * 2;
    const size_t tstep = 2 * hstep;
    const unsigned ldsw = (unsigned)wid * 1024u;
    const int aoff = lds_byte(wr * 64 + fr, fq * 8), boff = lds_byte(wc * 32 + fr, fq * 8);
#define PG8_SA(b, h) (((b) * 2 + (h)) * HTB)
#define PG8_SB(b, h) ((4 + (b) * 2 + (h)) * HTB)
#define PG8_STAGE(bufoff, gbase, voff) do { _Pragma("unroll") for (int _i = 0; _i < 2; ++_i) \
        __builtin_amdgcn_global_load_lds((const unsigned*)((const char*)(gbase) + (voff)[_i]), (PG8_LAS unsigned*)(lds + (bufoff) + ldsw + _i * 8192), 16, 0, 0); } while (0)
#define PG8_LDA(dst, b, h) do { _Pragma("unroll") for (int m = 0; m < 4; ++m) _Pragma("unroll") for (int k = 0; k < 2; ++k) dst[m][k] = *(const PG8_LAS bf16x8*)(lds + PG8_SA(b, h) + aoff + m * 2048 + k * 1024); } while (0)
#define PG8_LDB(dst, b, h) do { _Pragma("unroll") for (int n = 0; n < 2; ++n) _Pragma("unroll") for (int k = 0; k < 2; ++k) dst[n][k] = *(const PG8_LAS bf16x8*)(lds + PG8_SB(b, h) + boff + n * 2048 + k * 1024); } while (0)
#define PG8_MMA(ai, bj, At, Bt) do { __builtin_amdgcn_s_setprio(1); _Pragma("unroll") for (int m = 0; m < 4; ++m) _Pragma("unroll") for (int n = 0; n < 2; ++n) _Pragma("unroll") for (int k = 0; k < 2; ++k) \
        acc[ai][bj][m][n] = __builtin_amdgcn_mfma_f32_16x16x32_bf16(Bt[n][k], At[m][k], acc[ai][bj][m][n], 0, 0, 0); __builtin_amdgcn_s_setprio(0); } while (0)
#define PG8_WAIT_V(n) asm volatile("s_waitcnt vmcnt(" #n ")" ::: "memory")
#define PG8_WAIT_L(n) asm volatile("s_waitcnt lgkmcnt(" #n ")" ::: "memory")
#define PG8_BAR __builtin_amdgcn_s_barrier()
#define PG8_SCHED __builtin_amdgcn_sched_barrier(0)
    Unit cur, nxt; int ui = 0;
    if (!S.next(0, cur)) return;
    f32x4 acc[2][2][4][2];
#pragma unroll
    for (int a = 0; a < 2; ++a)
#pragma unroll
        for (int b = 0; b < 2; ++b)
#pragma unroll
            for (int m = 0; m < 4; ++m)
#pragma unroll
                for (int n = 0; n < 2; ++n) acc[a][b][m][n] = (f32x4){0.f, 0.f, 0.f, 0.f};
    bf16x8 At[4][2], B0[2][2], B1[2][2];
    const char* cA = (const char*)g.A + (size_t)cur.pm * tstep; const char* cB = (const char*)g.Bt + (size_t)cur.pn * tstep;
    if constexpr (KROT != 0) { cA += (size_t)KROT * kstep; cB += (size_t)KROT * kstep; }
    S.a_ready(cur);
    if constexpr (SP2) {
        PG8_STAGE(PG8_SB(0, 0), cB, voffB); PG8_STAGE(PG8_SB(0, 1), cB + hstep, voffB); PG8_STAGE(PG8_SA(0, 0), cA, voffA); PG8_STAGE(PG8_SA(0, 1), cA + hstep, voffA);
        if (wr == 1) PG8_BAR;
        PG8_WAIT_V(2); PG8_BAR;
        PG8_STAGE(PG8_SB(1, 0), cB + kstep, voffB); PG8_STAGE(PG8_SA(1, 0), cA + kstep, voffA); PG8_STAGE(PG8_SB(1, 1), cB + hstep + kstep, voffB);
        PG8_WAIT_V(6); PG8_BAR;
    } else {
        PG8_STAGE(PG8_SB(0, 0), cB, voffB); PG8_STAGE(PG8_SA(0, 0), cA, voffA); PG8_STAGE(PG8_SB(0, 1), cB + hstep, voffB); PG8_STAGE(PG8_SA(0, 1), cA + hstep, voffA);
        if (wr == 1) PG8_BAR;
        PG8_WAIT_V(4); PG8_BAR;
        PG8_STAGE(PG8_SB(1, 0), cB + kstep, voffB); PG8_STAGE(PG8_SA(1, 0), cA + kstep, voffA); PG8_STAGE(PG8_SB(1, 1), cB + hstep + kstep, voffB);
        PG8_WAIT_V(6); PG8_BAR;
    }
    for (;;) {
        const bool has_next = S.next(ui + 1, nxt);
        const char* nA = has_next ? (const char*)g.A + (size_t)nxt.pm * tstep : cA; const char* nB = has_next ? (const char*)g.Bt + (size_t)nxt.pn * tstep : cB;
        for (int t = 0; t < nt; t += 2) {
            const bool last = (t == nt - 2);
            const char* a1 = cA + (size_t)(t + 1) * kstep;
            if constexpr (KROT != 0) { if (t + 2 + KROT == nt) { cA -= (size_t)nt * kstep; cB -= (size_t)nt * kstep; } }
            const char* a2 = last ? nA : cA + (size_t)(t + 2) * kstep; const char* b2 = last ? nB : cB + (size_t)(t + 2) * kstep;
            const char* a3 = a2 + kstep; const char* b3 = b2 + kstep;
            if (last && has_next) S.a_ready(nxt);
            if constexpr (SP2) {
            PG8_LDB(B0, 0, 0); PG8_LDB(B1, 0, 1); PG8_SCHED; PG8_LDA(At, 0, 0); PG8_STAGE(PG8_SA(1, 1), a1 + hstep, voffA);
            PG8_WAIT_V(8); PG8_WAIT_L(0); PG8_BAR; PG8_MMA(0, 0, At, B0); PG8_MMA(0, 1, At, B1); PG8_BAR; PG8_SCHED;
            PG8_LDA(At, 0, 1); PG8_STAGE(PG8_SB(0, 0), b2, voffB); PG8_STAGE(PG8_SB(0, 1), b2 + hstep, voffB); PG8_STAGE(PG8_SA(0, 0), a2, voffA);
            PG8_WAIT_V(8); PG8_WAIT_L(0); PG8_BAR; PG8_MMA(1, 0, At, B0); PG8_MMA(1, 1, At, B1); PG8_BAR; PG8_SCHED;
            PG8_LDB(B0, 1, 0); PG8_LDB(B1, 1, 1); PG8_SCHED; PG8_LDA(At, 1, 0); PG8_STAGE(PG8_SA(0, 1), a2 + hstep, voffA);
            PG8_WAIT_V(8); PG8_WAIT_L(0); PG8_BAR; PG8_MMA(0, 0, At, B0); PG8_MMA(0, 1, At, B1); PG8_BAR; PG8_SCHED;
            PG8_LDA(At, 1, 1); PG8_STAGE(PG8_SB(1, 0), b3, voffB); PG8_STAGE(PG8_SB(1, 1), b3 + hstep, voffB); PG8_STAGE(PG8_SA(1, 0), a3, voffA);
            PG8_WAIT_V(8); PG8_WAIT_L(0); PG8_BAR; PG8_MMA(1, 0, At, B0); PG8_MMA(1, 1, At, B1); PG8_BAR; PG8_SCHED;
            } else {
            PG8_LDB(B0, 0, 0); PG8_SCHED; PG8_LDA(At, 0, 0); PG8_STAGE(PG8_SA(1, 1), a1 + hstep, voffA);
            PG8_WAIT_L(8); PG8_BAR; PG8_WAIT_L(0); PG8_MMA(0, 0, At, B0); PG8_BAR; PG8_SCHED;
            PG8_LDB(B1, 0, 1); PG8_STAGE(PG8_SB(0, 0), b2, voffB);
            PG8_BAR; PG8_WAIT_L(0); PG8_MMA(0, 1, At, B1); PG8_BAR;
            PG8_LDA(At, 0, 1); PG8_STAGE(PG8_SA(0, 0), a2, voffA);
            PG8_BAR; PG8_WAIT_L(0); PG8_MMA(1, 0, At, B0); PG8_BAR; PG8_SCHED;
            PG8_STAGE(PG8_SB(0, 1), b2 + hstep, voffB);
            PG8_WAIT_V(6); PG8_BAR; PG8_MMA(1, 1, At, B1); PG8_BAR;
            PG8_LDB(B0, 1, 0); PG8_SCHED; PG8_LDA(At, 1, 0); PG8_STAGE(PG8_SA(0, 1), a2 + hstep, voffA);
            PG8_WAIT_L(8); PG8_BAR; PG8_WAIT_L(0); PG8_MMA(0, 0, At, B0); PG8_BAR; PG8_SCHED;
            PG8_LDB(B1, 1, 1); PG8_STAGE(PG8_SB(1, 0), b3, voffB);
            PG8_BAR; PG8_WAIT_L(0); PG8_MMA(0, 1, At, B1); PG8_BAR;
            PG8_LDA(At, 1, 1); PG8_STAGE(PG8_SA(1, 0), a3, voffA);
            PG8_BAR; PG8_WAIT_L(0); PG8_MMA(1, 0, At, B0); PG8_BAR; PG8_SCHED;
            PG8_STAGE(PG8_SB(1, 1), b3 + hstep, voffB);
            PG8_WAIT_V(6); PG8_BAR; PG8_MMA(1, 1, At, B1); PG8_BAR;
            }
        }
        if constexpr (ALIGN_EPI) { if (wr == 0) PG8_BAR; }
        if constexpr (!Epi::AFTER_DRAIN) { E(acc, cur, wr, wc, fr, fq); S.done(cur); }
        if (!has_next) break;
#pragma unroll
        for (int a = 0; a < 2; ++a)
#pragma unroll
            for (int b = 0; b < 2; ++b)
#pragma unroll
                for (int m = 0; m < 4; ++m)
#pragma unroll
                    for (int n = 0; n < 2; ++n) acc[a][b][m][n] = (f32x4){0.f, 0.f, 0.f, 0.f};
        cur = nxt; cA = nA; cB = nB; ++ui;
        if constexpr (ALIGN_EPI) { if (wr == 1) PG8_BAR; }
    }
    PG8_WAIT_V(0);
    if constexpr (!ALIGN_EPI) { if (wr == 0) PG8_BAR; }
    PG8_BAR;
    if constexpr (Epi::AFTER_DRAIN) { E.fused(acc, cur, wr, wc, fr, fq, lds, wid, lane); S.done(cur); }
#undef PG8_SA
#undef PG8_SB
#undef PG8_STAGE
#undef PG8_LDA
#undef PG8_LDB
#undef PG8_MMA
#undef PG8_WAIT_V
#undef PG8_WAIT_L
#undef PG8_BAR
#undef PG8_SCHED
}
}
#define LAS __attribute__((address_space(3)))
typedef unsigned short bf16_t;
typedef float f32x4 __attribute__((ext_vector_type(4)));
typedef float f32x2 __attribute__((ext_vector_type(2)));
typedef float f32x16 __attribute__((ext_vector_type(16)));
typedef short bf16x8 __attribute__((ext_vector_type(8)));
typedef unsigned u32x4 __attribute__((ext_vector_type(4)));
typedef unsigned u32x2 __attribute__((ext_vector_type(2)));
typedef LAS unsigned char* ldsp_t;

constexpr int D = 1024, MROWS = 16384, MP = 8192, DFF = 2816;
constexpr float EPS = 1e-6f;
constexpr float C2 = 0.125f * 1.4426950408889634f;
constexpr float LOG2E = 1.4426950408889634f;

constexpr size_t OUT_X = 0, OUT_AK = 16777216, OUT_AV = 25165824, OUT_BK = 33554432, OUT_BV = 35651584, OUT_CK = 37748736, OUT_CV = 39845888, OUT_SD = 41943040;

constexpr size_t MiB = 1u << 20;
constexpr size_t WS_MODP = 150 * MiB + 192 * MiB;
constexpr size_t WS_TAB = 5 * MiB;
constexpr size_t WS_BIAS = WS_TAB + 512 * 1024;
constexpr size_t WS_ROPE = WS_BIAS + 1 * MiB;
constexpr size_t WS_SMALL = WS_ROPE + 16 * 1024;
constexpr size_t WS_RSS = 7 * MiB;
constexpr size_t WS_W = 10 * MiB;
constexpr size_t W_FF1 = WS_W;
constexpr size_t W_FF2 = W_FF1 + 44 * MiB;
constexpr size_t W_QKVA = W_FF2 + 22 * MiB;
constexpr size_t W_O = W_QKVA + 6 * MiB;
constexpr size_t W_QKVB = W_O + 8 * MiB;
constexpr size_t W_QKVC = W_QKVB + 3 * MiB;
constexpr size_t W_IND = W_QKVC + 3 * MiB;
constexpr size_t WS_CTX = 106 * MiB;
constexpr size_t CTX_KA = WS_CTX, CTX_VA = WS_CTX + 4 * MiB, CTX_KB = WS_CTX + 8 * MiB, CTX_VB = WS_CTX + 9 * MiB, CTX_KC = WS_CTX + 10 * MiB, CTX_VC = WS_CTX + 11 * MiB;
constexpr size_t WS_XS = 118 * MiB;
constexpr size_t WS_BIG = 150 * MiB;
constexpr size_t WS_XB = 342 * MiB;
constexpr size_t WS_END = 374 * MiB;
constexpr size_t B_Q = WS_BIG, B_K = WS_BIG + 32 * MiB, B_V = WS_BIG + 64 * MiB, B_O = WS_BIG + 96 * MiB;
constexpr size_t B_H = WS_BIG;
constexpr size_t B_DQ = WS_BIG, B_DV = WS_BIG + 32 * MiB, B_DG = WS_BIG + 64 * MiB, B_DLF = WS_BIG + 96 * MiB  , B_DOB = WS_BIG + 160 * MiB;

constexpr int SV_QNA = 0, SV_KNA = 64, SV_SUBLN = 128, SV_QNB = 256, SV_KNB = 320, SV_SINK = 384, SV_QNC = 448, SV_KNC = 512, SV_GND = 576, SV_LAM = 704, SV_OSC = 705, SV_LB = 1024;
constexpr int LDS_BYTES = 147456;
constexpr int NTHREADS = 512;

struct Params {
    const float* in[40];
    float* out;
    unsigned char* ws;
    int ph_lo, ph_hi;
};

typedef __bf16 bf16x2_t __attribute__((ext_vector_type(2)));
__device__ __forceinline__ unsigned cvt_pk(float lo, float hi) { const f32x2 v = {lo, hi}; const bf16x2_t b = __builtin_convertvector(v, bf16x2_t); return __builtin_bit_cast(unsigned, b); }
__device__ __forceinline__ unsigned short f2bf(float f) { return (unsigned short)(cvt_pk(f, 0.f) & 0xffffu); }
__device__ __forceinline__ float bf2f(unsigned short b) { return __builtin_bit_cast(float, (unsigned)b << 16); }
__device__ __forceinline__ float fast_exp(float x) { return __builtin_amdgcn_exp2f(x * LOG2E); }
__device__ __forceinline__ float silu_f(float x) { return x * __builtin_amdgcn_rcpf(1.f + fast_exp(-x)); }
__device__ __forceinline__ float sigmoid_f(float x) { return __builtin_amdgcn_rcpf(1.f + fast_exp(-x)); }
__device__ __forceinline__ float max3f(float a, float b, float c) { float r; asm("v_max3_f32 %0, %1, %2, %3" : "=v"(r) : "v"(a), "v"(b), "v"(c)); return r; }
__device__ __forceinline__ int crow(int r, int hi) { return (r & 3) + 8 * (r >> 2) + 4 * hi; }
__device__ __forceinline__ int grp_of_pm(int pm) { return pm < 32 ? 0 : 1 + ((pm - 32) >> 3); }
__device__ __forceinline__ float rstd_of(const float* rss, int row) { const f32x4 s = *(const f32x4*)(rss + (size_t)row * 4); return rsqrtf(((s.x + s.y) + (s.z + s.w)) * (1.f / 1024.f) + EPS); }
__device__ __forceinline__ float lane_xor16(float v) { const auto r = __builtin_amdgcn_permlane16_swap(__float_as_uint(v), __float_as_uint(v), false, false); const int l = __builtin_amdgcn_mbcnt_hi(~0u, __builtin_amdgcn_mbcnt_lo(~0u, 0u)); return __uint_as_float((l & 16) ? r[0] : r[1]); }
__device__ __forceinline__ float lane_xor32(float v) { const auto r = __builtin_amdgcn_permlane32_swap(__float_as_uint(v), __float_as_uint(v), false, false); const int l = __builtin_amdgcn_mbcnt_hi(~0u, __builtin_amdgcn_mbcnt_lo(~0u, 0u)); return __uint_as_float((l & 32) ? r[0] : r[1]); }
__device__ __forceinline__ float wave_sum(float v) {
    v += __uint_as_float((unsigned)__builtin_amdgcn_mov_dpp((int)__float_as_uint(v), 0xB1, 0xF, 0xF, true));
    v += __uint_as_float((unsigned)__builtin_amdgcn_mov_dpp((int)__float_as_uint(v), 0x4E, 0xF, 0xF, true));
    v += __uint_as_float((unsigned)__builtin_amdgcn_mov_dpp((int)__float_as_uint(v), 0x141, 0xF, 0xF, true));
    v += __uint_as_float((unsigned)__builtin_amdgcn_mov_dpp((int)__float_as_uint(v), 0x140, 0xF, 0xF, true));
    v += lane_xor16(v);
    v += lane_xor32(v);
    return v;
}
#define WG_BARRIER() __syncthreads()
__device__ __forceinline__ int fresh_tid(int wid_s) { unsigned m = ~0u; asm volatile("" : "+s"(m)); const int l = (int)__builtin_amdgcn_mbcnt_hi(m, __builtin_amdgcn_mbcnt_lo(m, 0u)); return wid_s * 64 + l; }
#define FRESH_TID(w) fresh_tid(w)
#define LAUNDER_S(p) asm volatile("" : "+s"(p))
#define OPAQUE_PTR(T, name, src) size_t name##_z = 0; LAUNDER_S(name##_z); T name = (src) + name##_z

using pg8::Unit;

__device__ __forceinline__ unsigned dpp_xor1(unsigned v) { return (unsigned)__builtin_amdgcn_mov_dpp((int)v, 0xB1, 0xF, 0xF, true); }
__device__ __forceinline__ unsigned dpp_xor2(unsigned v) { return (unsigned)__builtin_amdgcn_mov_dpp((int)v, 0x4E, 0xF, 0xF, true); }
template <int LAYER> struct EpiQKV {
    static constexpr bool PERM = true, AFTER_DRAIN = false;
    unsigned char* ws_; float* out_; int li;
    __device__ __forceinline__ void operator()(const f32x4 (&acc)[2][2][4][2], const Unit& u, int wr, int wc, int fr_, int fq_) const {
        int fr = fr_, fq = fq_; asm volatile("" : "+v"(fr), "+v"(fq));
        constexpr int NKT = (LAYER == 0) ? 4 : 1, KH = (LAYER == 0) ? 16 : 4, VH = (LAYER == 0) ? 8 : 4, DV = (LAYER == 0) ? 128 : 64;
        const int pn = u.pn, kind = pn < 4 ? 0 : (pn < 4 + NKT ? 1 : 2);
        const int g = grp_of_pm(u.pm); const bool sample = u.pm >= 32;
        OPAQUE_PTR(unsigned char*, ws, ws_); OPAQUE_PTR(float*, outp, out_);
        const float* rss = (const float*)(ws + WS_RSS) + (size_t)(2 * li) * MROWS * 4;
        const float* bias = (const float*)(ws + WS_BIAS) + (size_t)(2 * li) * 5 * 5632; constexpr int nstride = 5632;
        const float* sv = (const float*)(ws + WS_SMALL);
        const float* qg = sv + (li == 0 ? SV_QNA : (li == 1 ? SV_QNB : SV_QNC)); const float* kg = qg + 64;
        bf16_t* Q = (bf16_t*)(ws + B_Q); bf16_t* Kp = (bf16_t*)(ws + B_K); bf16_t* Ks = (bf16_t*)(ws + B_K + 16 * MiB); bf16_t* Vtp = (bf16_t*)(ws + B_V); bf16_t* Vts = (bf16_t*)(ws + B_V + 16 * MiB);
        float* outK = outp + (li == 0 ? OUT_AK : (li == 1 ? OUT_BK : OUT_CK)); float* outV = outp + (li == 0 ? OUT_AV : (li == 1 ? OUT_BV : OUT_CV));
        float rsv[2][4];
#pragma unroll
        for (int ai = 0; ai < 2; ++ai)
#pragma unroll
            for (int m = 0; m < 4; ++m) rsv[ai][m] = rstd_of(rss, u.pm * 256 + ai * 128 + wr * 64 + m * 16 + fr);
        float ifr[2][4];
#pragma unroll
        for (int n = 0; n < 2; ++n)
#pragma unroll
            for (int e = 0; e < 4; ++e) ifr[n][e] = __builtin_amdgcn_exp2f(-(float)(8 * (fq & 1) + 4 * n + e) * (13.287712379549449f / 16.f)) * 0.15915494309189535f;
        const float sgn = (fq & 2) ? 1.f : -1.f;
        f32x4 bv[2][2], gv[2][2];
#pragma unroll
        for (int bj = 0; bj < 2; ++bj)
#pragma unroll
            for (int n = 0; n < 2; ++n) {
                bv[bj][n] = *(const f32x4*)(bias + (size_t)g * nstride + pn * 256 + bj * 128 + wc * 32 + 8 * fq + 4 * n);
                gv[bj][n] = (kind < 2) ? *(const f32x4*)((kind == 0 ? qg : kg) + 32 * bj + 8 * fq + 4 * n) : (f32x4){1.f, 1.f, 1.f, 1.f};
            }
#pragma unroll
        for (int ai = 0; ai < 2; ++ai)
#pragma unroll
            for (int m = 0; m < 4; ++m) {
                const int row = u.pm * 256 + ai * 128 + wr * 64 + m * 16 + fr;
                const float rs = rsv[ai][m];
                const int b = sample ? ((row - MP) >> 11) : (row >> 8), t = sample ? ((row - MP) & 2047) : (row & 255);
                const int T = sample ? 2048 : 256;
                f32x4 v[2][2];
#pragma unroll
                for (int bj = 0; bj < 2; ++bj)
#pragma unroll
                    for (int n = 0; n < 2; ++n) v[bj][n] = acc[ai][bj][m][n] * rs + bv[bj][n];
                if (kind < 2) {
                    float ss = 0.f;
#pragma unroll
                    for (int bj = 0; bj < 2; ++bj)
#pragma unroll
                        for (int n = 0; n < 2; ++n) { const f32x4 x = v[bj][n]; ss += (x.x * x.x + x.y * x.y) + (x.z * x.z + x.w * x.w); }
                    ss += lane_xor16(ss); ss += lane_xor32(ss);
                    const float r = rsqrtf(ss * (1.f / 64.f) + EPS);
#pragma unroll
                    for (int bj = 0; bj < 2; ++bj)
#pragma unroll
                        for (int n = 0; n < 2; ++n) v[bj][n] = v[bj][n] * r * gv[bj][n];
                    if (sample) {
#pragma unroll
                        for (int bj = 0; bj < 2; ++bj) {
                            const float idx = (float)(bj ? (t & 63) : (t >> 6));
#pragma unroll
                            for (int n = 0; n < 2; ++n)
#pragma unroll
                                for (int e = 0; e < 4; ++e) {
                                    const float mine = v[bj][n][e];
                                    const auto sw = __builtin_amdgcn_permlane32_swap(__float_as_uint(mine), __float_as_uint(mine), false, false);
                                    const float other = __uint_as_float(fq & 2 ? sw[0] : sw[1]);
                                    const float rev = idx * ifr[n][e];
                                    v[bj][n][e] = mine * __builtin_amdgcn_cosf(rev) + sgn * other * __builtin_amdgcn_sinf(rev);
                                }
                        }
                    }
                    if (kind == 0) {
                        bf16_t* dst = Q + (size_t)row * 1024 + (pn * 4 + wc) * 64 + 8 * fq;
#pragma unroll
                        for (int bj = 0; bj < 2; ++bj) { const f32x4 x = v[bj][0] * C2, y = v[bj][1] * C2; u32x4 w; w.x = cvt_pk(x.x, x.y); w.y = cvt_pk(x.z, x.w); w.z = cvt_pk(y.x, y.y); w.w = cvt_pk(y.z, y.w); *(u32x4*)(dst + 32 * bj) = w; }
                    } else {
                        const int kh = (pn - 4) * 4 + wc;
                        bf16_t* dst = (sample ? Ks : Kp) + ((size_t)(b * KH + kh) * T + t) * 64 + 8 * fq;
#pragma unroll
                        for (int bj = 0; bj < 2; ++bj) { const f32x4 x = v[bj][0], y = v[bj][1]; u32x4 w; w.x = cvt_pk(x.x, x.y); w.y = cvt_pk(x.z, x.w); w.z = cvt_pk(y.x, y.y); w.w = cvt_pk(y.z, y.w); *(u32x4*)(dst + 32 * bj) = w;
                            if (!sample) { float* o = outK + (size_t)row * (KH * 64) + kh * 64 + 32 * bj + 8 * fq; *(f32x4*)o = x; *(f32x4*)(o + 4) = y; } }
                    }
                } else {
#pragma unroll
                    for (int bj = 0; bj < 2; ++bj) {
                        const int lcol = (pn - 4 - NKT) * 256 + 64 * wc + 32 * bj + 8 * fq;
                        const int vh = lcol / DV, d0 = lcol % DV;
                        const f32x4 x = v[bj][0], y = v[bj][1];
                        if (!sample) { float* o = outV + (size_t)row * (VH * DV) + lcol; *(f32x4*)o = x; *(f32x4*)(o + 4) = y; }
                        unsigned p0 = cvt_pk(x.x, x.y), p1 = cvt_pk(x.z, x.w), p2 = cvt_pk(y.x, y.y), p3 = cvt_pk(y.z, y.w);
                        const bool odd = fr & 1, hi2 = fr & 2;
                        const unsigned r0 = dpp_xor1(odd ? p0 : p1), r1 = dpp_xor1(odd ? p2 : p3);
                        const unsigned a0 = odd ? r0 : p0, a1 = odd ? p1 : r0, a2 = odd ? r1 : p2, a3 = odd ? p3 : r1;
                        const unsigned q0 = dpp_xor2(hi2 ? a0 : a2), q1 = dpp_xor2(hi2 ? a1 : a3);
                        const unsigned f0 = hi2 ? q0 : a0, f1 = hi2 ? q1 : a1, f2 = hi2 ? a2 : q0, f3 = hi2 ? a3 : q1;
                        u32x2 wlo, whi;
                        wlo.x = (f0 & 0xffffu) | (f1 << 16); wlo.y = (f2 & 0xffffu) | (f3 << 16); whi.x = (f0 >> 16) | (f1 & 0xffff0000u); whi.y = (f2 >> 16) | (f3 & 0xffff0000u);
                        bf16_t* dst = (sample ? Vts : Vtp) + ((size_t)(b * VH + vh) * DV + d0 + 2 * (fr & 3)) * T + (t & ~3);
                        *(u32x2*)dst = wlo; *(u32x2*)(dst + T) = whi;
                    }
                }
            }
    }
};

struct EpiInD {
    static constexpr bool PERM = true, AFTER_DRAIN = false;
    unsigned char* ws_;
    __device__ __forceinline__ void operator()(const f32x4 (&acc)[2][2][4][2], const Unit& u, int wr, int wc, int fr_, int fq_) const {
        int fr = fr_, fq = fq_; asm volatile("" : "+v"(fr), "+v"(fq));
        const int pn = u.pn, kind = pn >> 2;
        const int grp = grp_of_pm(u.pm);
        OPAQUE_PTR(unsigned char*, ws, ws_);
        const float* rss = (const float*)(ws + WS_RSS) + (size_t)6 * MROWS * 4;
        const float* bias = (const float*)(ws + WS_BIAS) + (size_t)6 * 5 * 5632; constexpr int nstride = 5632;
        const float* lbv = (const float*)(ws + WS_SMALL) + SV_LB;
        bf16_t* q = (bf16_t*)(ws + B_DQ); bf16_t* v = (bf16_t*)(ws + B_DV); bf16_t* g = (bf16_t*)(ws + B_DG); _Float16* lf = (_Float16*)(ws + B_DLF);
        float rs[2][4];
#pragma unroll
        for (int ai = 0; ai < 2; ++ai)
#pragma unroll
            for (int m = 0; m < 4; ++m) rs[ai][m] = rstd_of(rss, u.pm * 256 + ai * 128 + wr * 64 + m * 16 + fr);
        f32x4 bva[2][2], lba[2][2];
#pragma unroll
        for (int bj = 0; bj < 2; ++bj)
#pragma unroll
            for (int n = 0; n < 2; ++n) {
                bva[bj][n] = *(const f32x4*)(bias + (size_t)grp * nstride + pn * 256 + bj * 128 + wc * 32 + 8 * fq + 4 * n);
                lba[bj][n] = (kind == 1 || kind == 2) ? *(const f32x4*)(lbv + (kind - 1) * 1024 + (pn & 3) * 256 + 64 * wc + 32 * bj + 8 * fq + 4 * n) : (f32x4){0.f, 0.f, 0.f, 0.f};
            }
#pragma unroll
        for (int bj = 0; bj < 2; ++bj) {
            const int lcol = (pn & 3) * 256 + 64 * wc + 32 * bj + 8 * fq;
#pragma unroll
            for (int ai = 0; ai < 2; ++ai)
#pragma unroll
                for (int m = 0; m < 4; ++m) {
                    const int row = u.pm * 256 + ai * 128 + wr * 64 + m * 16 + fr;
                    f32x4 x = acc[ai][bj][m][0] * rs[ai][m] + bva[bj][0], y = acc[ai][bj][m][1] * rs[ai][m] + bva[bj][1];
                    if (kind == 1 || kind == 2) {
                        typedef _Float16 h8 __attribute__((ext_vector_type(8)));
                        h8 o;
#pragma unroll
                        for (int e = 0; e < 4; ++e) { const float l0 = lba[bj][0][e], l1 = lba[bj][1][e];
                            o[e] = (_Float16)__builtin_amdgcn_logf(l0 + (1.f - l0) * sigmoid_f(x[e]));
                            o[4 + e] = (_Float16)__builtin_amdgcn_logf(l1 + (1.f - l1) * sigmoid_f(y[e])); }
                        *(h8*)(lf + (size_t)row * 2048 + (kind - 1) * 1024 + lcol) = o;
                    } else {
                        if (kind == 0) { x.x = silu_f(x.x); x.y = silu_f(x.y); x.z = silu_f(x.z); x.w = silu_f(x.w); y.x = silu_f(y.x); y.y = silu_f(y.y); y.z = silu_f(y.z); y.w = silu_f(y.w); }
                        bf16_t* dst = (kind == 0 ? q : (kind == 3 ? v : g)) + (size_t)row * 1024 + lcol;
                        u32x4 w; w.x = cvt_pk(x.x, x.y); w.y = cvt_pk(x.z, x.w); w.z = cvt_pk(y.x, y.y); w.w = cvt_pk(y.z, y.w); *(u32x4*)dst = w;
                    }
                }
        }
    }
};

constexpr int EPI_LDS = 131072, EPI_SLOT = 2048, EPI_MAXU = 6;
__device__ __forceinline__ void stage_epi_rb(ldsp_t lds, const pg8::StaticOrder& S, const float* rss, const float* bias, int nstride, int wid_s) {
    const int tid = FRESH_TID(wid_s);
    for (int i = 0; i < EPI_MAXU; ++i) {
        Unit u; if (!S.next(i, u)) break;
        LAS float* sp = (LAS float*)(lds + EPI_LDS + i * EPI_SLOT);
        if (tid < 256) sp[tid] = rstd_of(rss, u.pm * 256 + tid);
        else sp[tid] = bias[(size_t)grp_of_pm(u.pm) * nstride + u.pn * 256 + (tid - 256)];
    }
    WG_BARRIER();
}

struct EpiSwiGLU {
    static constexpr bool PERM = true, AFTER_DRAIN = false;
    unsigned char* ws_; int li; ldsp_t lds_;
    __device__ __forceinline__ void operator()(const f32x4 (&acc)[2][2][4][2], const Unit& u, int wr, int wc, int fr_, int fq_) const {
        int fr = fr_, fq = fq_; asm volatile("" : "+v"(fr), "+v"(fq));
        const int pn = u.pn;
        OPAQUE_PTR(unsigned char*, ws, ws_);
        const LAS float* sp = (const LAS float*)(lds_ + EPI_LDS + u.idx * EPI_SLOT);
        bf16_t* H = (bf16_t*)(ws + B_H);
        float rs[2][4];
#pragma unroll
        for (int ai = 0; ai < 2; ++ai)
#pragma unroll
            for (int m = 0; m < 4; ++m) rs[ai][m] = sp[ai * 128 + wr * 64 + m * 16 + fr];
        f32x4 bga[2], bua[2];
#pragma unroll
        for (int n = 0; n < 2; ++n) { const LAS float* bp = sp + 256 + wc * 32 + 8 * fq + 4 * n; bga[n] = *(const LAS f32x4*)(bp); bua[n] = *(const LAS f32x4*)(bp + 128); }
#pragma unroll
        for (int ai = 0; ai < 2; ++ai)
#pragma unroll
            for (int m = 0; m < 4; ++m) {
                const int row = u.pm * 256 + ai * 128 + wr * 64 + m * 16 + fr;
                u32x4 w;
#pragma unroll
                for (int n = 0; n < 2; ++n) {
                    const f32x4 gt = acc[ai][0][m][n] * rs[ai][m] + bga[n], up = acc[ai][1][m][n] * rs[ai][m] + bua[n];
                    const float h0 = silu_f(gt.x) * up.x, h1 = silu_f(gt.y) * up.y, h2 = silu_f(gt.z) * up.z, h3 = silu_f(gt.w) * up.w;
                    if (n == 0) { w.x = cvt_pk(h0, h1); w.y = cvt_pk(h2, h3); } else { w.z = cvt_pk(h0, h1); w.w = cvt_pk(h2, h3); }
                }
                *(u32x4*)(H + (size_t)row * DFF + pn * 128 + wc * 32 + 8 * fq) = w;
            }
    }
};

struct EpiRes {
    static constexpr bool PERM = true, AFTER_DRAIN = true;
    const float* xin_p; const float* xin_s; unsigned char* ws_; float* out_; int li; int ffn;
    __device__ __forceinline__ void fused(f32x4 (&acc)[2][2][4][2], const Unit& u, int wr, int wc, int fr_, int fq_, PG8_LAS unsigned char* lds, int wid, int lane) const {
        int fr = fr_, fq = fq_; asm volatile("" : "+v"(fr), "+v"(fq));
        const int pn = u.pn, grp = grp_of_pm(u.pm);
        OPAQUE_PTR(unsigned char*, ws, ws_); OPAQUE_PTR(float*, X, out_);
        const float* TAB = (const float*)(ws + WS_TAB);
        const float* gate = TAB + (size_t)li * 5 * 4096 + (ffn ? 3072 : 1024);
        const float* cs = ffn ? (li < 3 ? TAB + (size_t)(li + 1) * 5 * 4096 : (const float*)nullptr) : TAB + (size_t)li * 5 * 4096 + 2048;
        bf16_t* xs = (bf16_t*)(ws + WS_XS);
        float* rss_out = (float*)(ws + WS_RSS) + (size_t)(ffn ? (li < 3 ? 2 * li + 2 : 7) : 2 * li + 1) * MROWS * 4;
        LAS float* P = (LAS float*)lds;
        const bool src_f32 = (li == 0 && !ffn), dst_f32 = (li == 3 && ffn);
        const float* xbase = (u.pm < 32) ? (xin_p + (size_t)(u.pm * 256) * 1024) : (xin_s + (size_t)(u.pm * 256 - MP) * 1024);
        bf16_t* xb = (bf16_t*)(ws + WS_XB) + (size_t)(u.pm * 256) * 1024;
        float* xo = X + (size_t)(u.pm * 256) * 1024;
        float ss[2][4];
#pragma unroll
        for (int ai = 0; ai < 2; ++ai)
#pragma unroll
            for (int m = 0; m < 4; ++m) ss[ai][m] = 0.f;
#pragma unroll
        for (int bj = 0; bj < 2; ++bj) {
            asm volatile("" ::: "memory");
            const int col = pn * 256 + bj * 128 + wc * 32 + 8 * fq;
            const f32x4 g0 = *(const f32x4*)(gate + (size_t)grp * 4096 + col), g1 = *(const f32x4*)(gate + (size_t)grp * 4096 + col + 4);
            const f32x4 c0 = cs ? *(const f32x4*)(cs + (size_t)grp * 4096 + col) : (f32x4){0.f, 0.f, 0.f, 0.f}, c1 = cs ? *(const f32x4*)(cs + (size_t)grp * 4096 + col + 4) : (f32x4){0.f, 0.f, 0.f, 0.f};
#pragma unroll
            for (int ai = 0; ai < 2; ++ai)
#pragma unroll
                for (int m = 0; m < 4; ++m) {
                    const int rl = ai * 128 + wr * 64 + m * 16 + fr;
                    f32x4 x0, x1;
                    if (src_f32) { x0 = *(const f32x4*)(xbase + (size_t)rl * 1024 + col); x1 = *(const f32x4*)(xbase + (size_t)rl * 1024 + col + 4); }
                    else { const u32x4 w = *(const u32x4*)(xb + (size_t)rl * 1024 + col);
                        x0 = (f32x4){bf2f(w.x & 0xffff), bf2f(w.x >> 16), bf2f(w.y & 0xffff), bf2f(w.y >> 16)}; x1 = (f32x4){bf2f(w.z & 0xffff), bf2f(w.z >> 16), bf2f(w.w & 0xffff), bf2f(w.w >> 16)}; }
                    const f32x4 n0 = x0 + g0 * acc[ai][bj][m][0], n1 = x1 + g1 * acc[ai][bj][m][1];
                    { if (dst_f32) { *(f32x4*)(xo + (size_t)rl * 1024 + col) = n0; *(f32x4*)(xo + (size_t)rl * 1024 + col + 4) = n1; }
                                else { u32x4 w; w.x = cvt_pk(n0.x, n0.y); w.y = cvt_pk(n0.z, n0.w); w.z = cvt_pk(n1.x, n1.y); w.w = cvt_pk(n1.z, n1.w); *(u32x4*)(xb + (size_t)rl * 1024 + col) = w; } }
                    if (cs) {
                        ss[ai][m] += ((n0.x * n0.x + n0.y * n0.y) + (n0.z * n0.z + n0.w * n0.w)) + ((n1.x * n1.x + n1.y * n1.y) + (n1.z * n1.z + n1.w * n1.w));
                        const f32x4 y0 = n0 * c0, y1 = n1 * c1; u32x4 w; w.x = cvt_pk(y0.x, y0.y); w.y = cvt_pk(y0.z, y0.w); w.z = cvt_pk(y1.x, y1.y); w.w = cvt_pk(y1.z, y1.w);
                        *(u32x4*)(xs + (size_t)(u.pm * 256 + rl) * 1024 + col) = w;
                    }
                }
        }
        if (cs) {
#pragma unroll
            for (int ai = 0; ai < 2; ++ai)
#pragma unroll
                for (int m = 0; m < 4; ++m) { float t = ss[ai][m]; t += lane_xor16(t); t += lane_xor32(t); if (fq == 0) P[(ai * 128 + wr * 64 + m * 16 + fr) * 4 + wc] = t; }
            WG_BARRIER();
            const int tid = wid * 64 + lane;
            if (tid < 256) { const f32x4 p = *(const LAS f32x4*)(P + tid * 4); rss_out[(size_t)(u.pm * 256 + tid) * 4 + pn] = (p.x + p.y) + (p.z + p.w); }
            WG_BARRIER();
        }
    }
};

struct AttnArgs {
    const bf16_t* Q; const bf16_t* Kp; const bf16_t* Ks; const bf16_t* Vtp; const bf16_t* Vts; const bf16_t* cK; const bf16_t* cVt; bf16_t* O;
    const float* sink; int window; float lam; float osc; const float* subln;
};

#define AT_MFMA(a, b, c) __builtin_amdgcn_mfma_f32_32x32x16_bf16(a, b, c, 0, 0, 0)
#define AT_PIN(x) asm volatile("" : "+v"(x))
#define AT_SB() __builtin_amdgcn_sched_barrier(0)
template <int MODE>
__device__ __forceinline__ void attn_unit_rs(ldsp_t lds, const AttnArgs& A, int stream, int b, int hd, int qb, int wid_s) {
    constexpr int DV = MODE == 0 ? 128 : 64, KH = MODE == 0 ? 16 : 4, VH = MODE == 0 ? 8 : 4, NS = MODE == 0 ? 2 : 1, NDB = DV / 32, NPV = 4 * NDB, VPRE = MODE == 0 ? 4 : 8;
    constexpr int NSLOT = MODE == 1 ? 6 : 3, AHEAD = MODE == 1 ? 2 : 1;
    constexpr bool NIC = MODE == 1;
    constexpr int NVL = DV / 64, KBYTES = 64 * 144, VBYTES = DV * 144, STAGE = NS * KBYTES + VBYTES;
    int wid_o = wid_s; asm volatile("" : "+s"(wid_o));
    const int tid = FRESH_TID(wid_s), lane = tid & 63, wid = wid_o, l31 = lane & 31, hi = lane >> 5;
    const int T = stream ? 2048 : 256, base_row = stream ? MP + b * 2048 : b * 256;
    const int msub = MODE == 0 ? (wid & 1) : 0, rb = MODE == 0 ? (wid >> 1) : (wid >> 2);
    const int qhead = MODE == 0 ? 2 * hd + msub : 4 * hd + (wid & 3);
    const int qrow0 = qb * (MODE == 0 ? 128 : 64) + rb * 32;
    const int nctx = stream ? 8 : 0;
    int tlo = 0, thi = T / 64;
    if (A.window && stream) { tlo = qb - 2 < 0 ? 0 : qb - 2; thi = (qb + 2 > 31 ? 31 : qb + 2) + 1; }
    const int NT = nctx + (thi - tlo);
    const bf16_t* Kown = stream ? A.Ks : A.Kp; const bf16_t* Vown = stream ? A.Vts : A.Vtp;
    u32x4 kreg[NS], vreg[NVL];
    auto load_tile = [&](int j) {
        const bool isctx = j < nctx; const int tt = isctx ? j : tlo + (j - nctx); const int TT = isctx ? 512 : T;
        const bf16_t* kb = isctx ? A.cK : Kown; const bf16_t* vb = isctx ? A.cVt : Vown;
#pragma unroll
        for (int s = 0; s < NS; ++s) { const int kh = MODE == 0 ? 2 * hd + s : hd; kreg[s] = *(const u32x4*)(kb + ((size_t)(b * KH + kh) * TT + 64 * tt) * 64 + tid * 8); }
#pragma unroll
        for (int i = 0; i < NVL; ++i) { const int d = (tid >> 3) + 64 * i; vreg[i] = *(const u32x4*)(vb + ((size_t)(b * VH + hd) * DV + d) * TT + 64 * tt + (tid & 7) * 8); }
    };
    auto store_tile = [&](int boff) {
        ldsp_t base = lds + boff;
#pragma unroll
        for (int s = 0; s < NS; ++s) *(LAS u32x4*)(base + s * KBYTES + (tid >> 3) * 144 + (tid & 7) * 16) = kreg[s];
#pragma unroll
        for (int i = 0; i < NVL; ++i) { ldsp_t p = base + NS * KBYTES + ((tid >> 3) + 64 * i) * 144 + (tid & 6) * 16 + (tid & 1) * 8;
            *(LAS u32x2*)(p) = (u32x2){vreg[i].x, vreg[i].y}; *(LAS u32x2*)(p + 16) = (u32x2){vreg[i].z, vreg[i].w}; }
    };
    auto slot = [&](int t) { return (t % NSLOT) * STAGE; };
    load_tile(0);
    bf16x8 qf[4];
    {
        const bf16_t* qp = A.Q + (size_t)(base_row + qrow0 + l31) * 1024 + qhead * 64 + hi * 8;
#pragma unroll
        for (int ds = 0; ds < 4; ++ds) qf[ds] = *(const bf16x8*)(qp + ds * 16);
    }
    constexpr float THR = 4.f;
    float mrun, lrun; bool first;
    if (A.sink) { mrun = A.sink[qhead] * LOG2E; lrun = hi == 0 ? 1.f : 0.f; first = false; } else { mrun = 0.f; lrun = 0.f; first = true; }
    f32x16 negm;
#pragma unroll
    for (int r = 0; r < 16; ++r) negm[r] = -mrun;
    f32x16 o[NDB];
#pragma unroll
    for (int i = 0; i < NDB; ++i) o[i] = f32x16{};
    ldsp_t kp0 = lds + msub * KBYTES + l31 * 144 + hi * 16;
    ldsp_t vp0 = lds + NS * KBYTES + l31 * 144 + hi * 16;
    auto mask_tile = [&](f32x16& C0, f32x16& C1, int j) {
        if (A.window && stream && j >= nctx) {
            const int tt = tlo + (j - nctx), qpos = qrow0 + l31;
            if (tt == qb - 2) {
                int th = qpos - 128 - 64 * tt - 4 * hi; asm volatile("" : "+v"(th));
#pragma unroll
                for (int r = 0; r < 16; ++r) { const int cr = (r & 3) + 8 * (r >> 2); if (cr < th) C0[r] = -1e30f; if (cr + 32 < th) C1[r] = -1e30f; }
            } else if (tt == qb + 2) {
                int th = qpos + 128 - 64 * tt - 4 * hi; asm volatile("" : "+v"(th));
#pragma unroll
                for (int r = 0; r < 16; ++r) { const int cr = (r & 3) + 8 * (r >> 2); if (cr > th) C0[r] = -1e30f; if (cr + 32 > th) C1[r] = -1e30f; }
            }
        }
    };
    auto row_max = [&](f32x16& C0, f32x16& C1) {
        asm volatile("s_nop 15\n\ts_nop 7" : "+v"(C0), "+v"(C1));
        float a = max3f(C0[0], C0[1], C1[0]), bb = max3f(C0[2], C0[3], C1[1]); a = max3f(a, C1[2], C1[3]);
#pragma unroll
        for (int r = 4; r < 16; r += 4) { a = max3f(a, C0[r], C0[r + 1]); bb = max3f(bb, C0[r + 2], C0[r + 3]); a = max3f(a, C1[r], C1[r + 1]); bb = max3f(bb, C1[r + 2], C1[r + 3]); }
        float mx = max3f(a, bb, bb);
        const auto rr = __builtin_amdgcn_permlane32_swap(__float_as_uint(mx), __float_as_uint(mx), false, false);
        return fmaxf(__uint_as_float(rr[0]), __uint_as_float(rr[1]));
    };
    auto step_end = [&]() { asm volatile("s_waitcnt lgkmcnt(0)\n\ts_barrier" ::: "memory"); };
    f32x16 pA0, pA1, pB0, pB1;
    store_tile(slot(0)); if (NT > 1) load_tile(1);
    if (AHEAD == 2) { if (NT > 1) store_tile(slot(1)); if (NT > 2) load_tile(2); }
    step_end();
    {
        bf16x8 kf[8];
#pragma unroll
        for (int g = 0; g < 8; ++g) kf[g] = *(const LAS bf16x8*)(kp0 + (g & 1) * 4608 + (g >> 1) * 32);
#pragma unroll
        for (int ds = 0; ds < 4; ++ds) { pA0 = AT_MFMA(kf[2 * ds], qf[ds], ds == 0 ? (NIC ? negm : f32x16{}) : pA0); pA1 = AT_MFMA(kf[2 * ds + 1], qf[ds], ds == 0 ? (NIC ? negm : f32x16{}) : pA1); }
        mask_tile(pA0, pA1, 0);
        const float mx = NIC ? row_max(pA0, pA1) : row_max(pA0, pA1) - mrun;
        if (first || __any(mx > THR)) {
            const float dl = first ? mx : fmaxf(mx, 0.f);
            mrun += dl;
            if (NIC) {
#pragma unroll
                for (int r = 0; r < 16; ++r) { pA0[r] -= dl; pA1[r] -= dl; negm[r] = -mrun; }
            }
            lrun *= __builtin_amdgcn_exp2f(-dl);
        }
        { const float nm = NIC ? 0.f : -mrun;
#pragma unroll
        for (int r = 0; r < 16; ++r) { pA0[r] = __builtin_amdgcn_exp2f(NIC ? pA0[r] : pA0[r] + nm); pA1[r] = __builtin_amdgcn_exp2f(NIC ? pA1[r] : pA1[r] + nm); } }
        if (NT > AHEAD) store_tile(slot(AHEAD));
        if (NT > AHEAD + 1) load_tile(AHEAD + 1);
        step_end();
    }
    u32x4 pw[4]; bf16x8 vfr[NPV];
#define AT_VRD(i, vb_) do { const int k_ = (i) / NDB, db_ = (i) % NDB; vfr[i] = *(const LAS bf16x8*)((vb_) + db_ * 4608 + k_ * 32); } while (0)
#define AT_VF(i) vfr[i]
#define AT_PWF(k) __builtin_bit_cast(bf16x8, pw[k])
    auto step = [&](f32x16& C0, f32x16& C1, f32x16& P0, f32x16& P1, int j) __attribute__((always_inline)) {
        if (j + AHEAD < NT) store_tile(slot(j + AHEAD));
        if (j + AHEAD + 1 < NT) load_tile(j + AHEAD + 1);
        bf16x8 kf[8];
        ldsp_t kb_ = kp0 + slot(j); ldsp_t vb_ = vp0 + slot(j - 1);
        kf[0] = *(const LAS bf16x8*)(kb_); kf[1] = *(const LAS bf16x8*)(kb_ + 4608);
        AT_SB();
        float sacc = 0.f;
#define AT_GA(g, CN, P) do { if ((g) + 2 < 8) kf[((g) + 2) & 7] = *(const LAS bf16x8*)(kb_ + (((g) + 2) & 1) * 4608 + (((g) + 2) >> 1) * 32); if ((g) < VPRE) AT_VRD(((g) < VPRE ? (g) : 0), vb_); AT_SB(); \
        CN = AT_MFMA(kf[g], qf[(g) >> 1], (g) < 2 ? (NIC ? negm : f32x16{}) : CN); \
        sacc += P[4 * ((g) & 3)]; sacc += P[4 * ((g) & 3) + 1]; sacc += P[4 * ((g) & 3) + 2]; sacc += P[4 * ((g) & 3) + 3]; \
        pw[(g) >> 1][2 * ((g) & 1)] = cvt_pk(P[4 * ((g) & 3)], P[4 * ((g) & 3) + 1]); pw[(g) >> 1][2 * ((g) & 1) + 1] = cvt_pk(P[4 * ((g) & 3) + 2], P[4 * ((g) & 3) + 3]); \
        AT_PIN(pw[(g) >> 1]); AT_PIN(sacc); AT_SB(); } while (0)
        AT_GA(0, C0, P0); AT_GA(1, C1, P0); AT_GA(2, C0, P0); AT_GA(3, C1, P0); AT_GA(4, C0, P1); AT_GA(5, C1, P1); AT_GA(6, C0, P1); AT_GA(7, C1, P1);
        lrun += sacc;
        mask_tile(C0, C1, j);
        const float mx = NIC ? row_max(C0, C1) : row_max(C0, C1) - mrun;
        bool resc = false; float alpha = 1.f;
        if (__builtin_expect(__any(mx > THR), 0)) {
            const float dl = fmaxf(mx, 0.f);
            mrun += dl;
            if (NIC) {
#pragma unroll
                for (int r = 0; r < 16; ++r) { C0[r] -= dl; C1[r] -= dl; negm[r] = -mrun; }
            }
            alpha = __builtin_amdgcn_exp2f(-dl); lrun *= alpha; resc = true;
        }
        float nm = NIC ? 0.f : -mrun; AT_PIN(nm);
        AT_SB();
        constexpr int EPG = 32 / NPV;
#pragma unroll
        for (int i = 0; i < NPV; ++i) {
            if (i + VPRE < NPV) { AT_VRD((i + VPRE < NPV ? i + VPRE : 0), vb_); AT_SB(); }
            o[i % NDB] = AT_MFMA(AT_VF(i), AT_PWF(i / NDB), o[i % NDB]);
            f32x16& X = (i * EPG) < 16 ? C0 : C1;
#pragma unroll
            for (int e = 0; e < EPG; ++e) X[(i * EPG + e) & 15] = __builtin_amdgcn_exp2f(NIC ? X[(i * EPG + e) & 15] : X[(i * EPG + e) & 15] + nm);
            AT_PIN(X); AT_SB();
        }
        if (resc) {
#pragma unroll
            for (int d = 0; d < NDB; ++d)
#pragma unroll
                for (int r = 0; r < 16; ++r) o[d][r] *= alpha;
        }
        if (AHEAD == 1 || (j & 1) == 0) step_end();
    };
    auto drain = [&](f32x16& P0, f32x16& P1) __attribute__((always_inline)) {
        ldsp_t vb_ = vp0 + slot(NT - 1);
        float sacc = 0.f;
#pragma unroll
        for (int r = 0; r < 16; ++r) sacc += P0[r] + P1[r];
        lrun += sacc;
#pragma unroll
        for (int k = 0; k < 4; ++k) { const f32x16& P = k < 2 ? P0 : P1; const int s8 = 8 * (k & 1);
            pw[k] = (u32x4){cvt_pk(P[s8], P[s8 + 1]), cvt_pk(P[s8 + 2], P[s8 + 3]), cvt_pk(P[s8 + 4], P[s8 + 5]), cvt_pk(P[s8 + 6], P[s8 + 7])}; }
#pragma unroll
        for (int i = 0; i < NPV; ++i) { AT_VRD(i, vb_); o[i % NDB] = AT_MFMA(AT_VF(i), AT_PWF(i / NDB), o[i % NDB]); }
    };
    int j = 1;
    for (; j + 1 < NT; j += 2) { step(pB0, pB1, pA0, pA1, j); step(pA0, pA1, pB0, pB1, j + 1); }
    if (j < NT) { step(pB0, pB1, pA0, pA1, j); drain(pB0, pB1); } else drain(pA0, pA1);
    asm volatile("s_waitcnt lgkmcnt(0)\n\ts_barrier" ::: "memory");
#undef AT_VRD
#undef AT_VF
#undef AT_PWF
#undef AT_GA
    const float ltot = lrun + __shfl_xor(lrun, 32);
    const float inv = 1.f / ltot;
    bf16_t* orow = A.O + (size_t)(base_row + qrow0 + l31) * 1024;
    if (MODE == 1) {
        bf16_t* dst = orow + qhead * 64;
#pragma unroll
        for (int db = 0; db < NDB; ++db)
#pragma unroll
            for (int g4 = 0; g4 < 4; ++g4) { u32x2 w; w.x = cvt_pk(o[db][4 * g4] * inv, o[db][4 * g4 + 1] * inv); w.y = cvt_pk(o[db][4 * g4 + 2] * inv, o[db][4 * g4 + 3] * inv);
                *(u32x2*)(dst + 32 * db + 8 * g4 + 4 * hi) = w; }
    } else {
        LAS float* X = (LAS float*)lds + (size_t)rb * 4096;
        if (msub == 1) {
            const float sc = inv * A.lam;
#pragma unroll
            for (int db = 0; db < NDB; ++db)
#pragma unroll
                for (int r = 0; r < 16; ++r) X[(db * 16 + r) * 64 + lane] = o[db][r] * sc;
        }
        WG_BARRIER();
        if (msub == 0) {
            float ss = 0.f;
#pragma unroll
            for (int db = 0; db < NDB; ++db)
#pragma unroll
                for (int r = 0; r < 16; ++r) { const float v = o[db][r] * inv - X[(db * 16 + r) * 64 + lane]; o[db][r] = v; ss += v * v; }
            ss += lane_xor32(ss);
            const float rn = rsqrtf(ss * (1.f / 128.f) + EPS) * A.osc;
            bf16_t* dst = orow + hd * 128;
#pragma unroll
            for (int db = 0; db < NDB; ++db)
#pragma unroll
                for (int g4 = 0; g4 < 4; ++g4) { const int d0 = 32 * db + 8 * g4 + 4 * hi; const f32x4 sg = *(const f32x4*)(A.subln + d0);
                    u32x2 w; w.x = cvt_pk(o[db][4 * g4] * rn * sg.x, o[db][4 * g4 + 1] * rn * sg.y); w.y = cvt_pk(o[db][4 * g4 + 2] * rn * sg.z, o[db][4 * g4 + 3] * rn * sg.w);
                    *(u32x2*)(dst + d0) = w; }
        }
        WG_BARRIER();
    }
}

constexpr int G_QD = 0, G_KIN = 17408, G_KOT = 34816, G_VT = 52224, G_ATT = 60928, G_ST0 = 70144, G_ST1 = 87552, G_DEC = 104960, G_SEG = 105472  ;
struct GlaArgs { const bf16_t* q; const bf16_t* v; const _Float16* lf; bf16_t* o_f; bf16_t* o_b; const float* s0; float* sout; };

struct GlaRegs { _Float16 rl[16]; bf16_t rq[16]; u32x4 rv; };
__device__ __forceinline__ void gla_fetch(const GlaArgs& A, GlaRegs& R, int uc, int n, int tid) {
    const int sk = tid & 127, seg = tid >> 7, vt_t = tid >> 3, vt_ch = tid & 7;
    const int st_ = uc < 128 ? 1 : 0, v_ = st_ ? uc : uc - 128, b_ = v_ >> 5, h_ = (v_ >> 2) & 7, d_ = (v_ >> 1) & 1, vh_ = v_ & 1;
    const int nc_ = st_ ? 32 : 4, br_ = st_ ? MP + b_ * 2048 : b_ * 256;
    const int cidx = d_ ? nc_ - 1 - n : n; const int row0 = br_ + cidx * 64;
    const _Float16* lp = A.lf + (size_t)row0 * 2048 + d_ * 1024 + h_ * 128 + sk;
    const bf16_t* qp = A.q + (size_t)row0 * 1024 + h_ * 128 + sk;
#pragma unroll
    for (int i = 0; i < 16; ++i) { const int p = 16 * seg + i, t = d_ ? 63 - p : p; R.rl[i] = lp[(size_t)t * 2048]; R.rq[i] = qp[(size_t)t * 1024]; }
    R.rv = *(const u32x4*)(A.v + (size_t)(row0 + vt_t) * 1024 + h_ * 128 + vh_ * 64 + vt_ch * 8);
}
__device__ __forceinline__ void gla_unit(ldsp_t lds, const GlaArgs& A, int ucode, int unext, GlaRegs& R, int wid_s) {
    const int stream = ucode < 128 ? 1 : 0, uv = stream ? ucode : ucode - 128, b = uv >> 5, h = (uv >> 2) & 7, dir = (uv >> 1) & 1, vhalf = uv & 1;
    int wid_o = wid_s; asm volatile("" : "+s"(wid_o));
    const int tid = FRESH_TID(wid_s), lane = tid & 63, wid = wid_o, l31 = lane & 31, hi = lane >> 5;
    const int kb = wid & 3, vb = wid >> 2;
    const int T = stream ? 2048 : 256, NC = T / 64, base_row = stream ? MP + b * 2048 : b * 256;
    const int sk = tid & 127, seg = tid >> 7;
    const int vt_t = tid >> 3, vt_ch = tid & 7;
    f32x16 S = f32x16{};
    if (stream) {
        const float* sp = A.s0 + ((size_t)(b * 2 + dir) * 8 + h) * 16384;
#pragma unroll
        for (int r = 0; r < 16; ++r) S[r] = sp[(32 * kb + crow(r, hi)) * 128 + vhalf * 64 + 32 * vb + l31];
    }
    auto publish = [&](int which) {
        ldsp_t st = lds + (which ? G_ST1 : G_ST0) + (32 * vb + l31) * 272;
#pragma unroll
        for (int g4 = 0; g4 < 4; ++g4) { u32x2 w; w.x = cvt_pk(S[4 * g4], S[4 * g4 + 1]); w.y = cvt_pk(S[4 * g4 + 2], S[4 * g4 + 3]); *(LAS u32x2*)(st + (32 * kb + 8 * g4 + 4 * hi) * 2) = w; }
    };
    publish(0);
    int cur = 0;
    bf16_t* obuf = dir ? A.o_b : A.o_f;
    for (int n = 0; n < NC; ++n) {
        const int cidx = dir ? NC - 1 - n : n; const int row0 = base_row + cidx * 64;
        float c[16], kk[16]; float run = 1.f;
#pragma unroll
        for (int i = 0; i < 16; ++i) { const float f = __builtin_amdgcn_exp2f((float)R.rl[i]); kk[i] = 1.f - f; run *= f; c[i] = run; }
        *(LAS float*)(lds + G_SEG + (seg * 128 + sk) * 4) = run;
        {
            ldsp_t p = lds + G_VT + (vt_ch * 8) * 136 + vt_t * 2;
            *(LAS bf16_t*)(p) = (bf16_t)(R.rv.x & 0xffff); *(LAS bf16_t*)(p + 136) = (bf16_t)(R.rv.x >> 16);
            *(LAS bf16_t*)(p + 2 * 136) = (bf16_t)(R.rv.y & 0xffff); *(LAS bf16_t*)(p + 3 * 136) = (bf16_t)(R.rv.y >> 16);
            *(LAS bf16_t*)(p + 4 * 136) = (bf16_t)(R.rv.z & 0xffff); *(LAS bf16_t*)(p + 5 * 136) = (bf16_t)(R.rv.z >> 16);
            *(LAS bf16_t*)(p + 6 * 136) = (bf16_t)(R.rv.w & 0xffff); *(LAS bf16_t*)(p + 7 * 136) = (bf16_t)(R.rv.w >> 16);
        }
        WG_BARRIER();
        {
            const float s0 = *(const LAS float*)(lds + G_SEG + (0 * 128 + sk) * 4), s1 = *(const LAS float*)(lds + G_SEG + (1 * 128 + sk) * 4);
            const float s2 = *(const LAS float*)(lds + G_SEG + (2 * 128 + sk) * 4), s3 = *(const LAS float*)(lds + G_SEG + (3 * 128 + sk) * 4);
            const float tot = (s0 * s1) * (s2 * s3);
            const float pre = seg == 0 ? 1.f : (seg == 1 ? s0 : (seg == 2 ? s0 * s1 : s0 * s1 * s2));
            if (seg == 0) *(LAS float*)(lds + G_DEC + sk * 4) = tot;
            const f32x2 pre2 = {pre, pre}, tot2 = {tot, tot};
            unsigned ko[8];
#pragma unroll
            for (int i = 0; i < 16; i += 2) {
                const f32x2 e = (f32x2){c[i], c[i + 1]} * pre2;
                const f32x2 r = {__builtin_amdgcn_rcpf(e.x), __builtin_amdgcn_rcpf(e.y)};
                const unsigned qw = (unsigned)R.rq[i] | ((unsigned)R.rq[i + 1] << 16);
                const f32x2 qf = {__builtin_bit_cast(float, qw << 16), __builtin_bit_cast(float, qw & 0xffff0000u)};
                const f32x2 qd = qf * e, ki = (f32x2){kk[i], kk[i + 1]} * r, kt = ki * tot2;
                const unsigned wq = cvt_pk(qd.x, qd.y), wk = cvt_pk(ki.x, ki.y);
                const int p0 = 16 * seg + i, t0 = dir ? 63 - p0 : p0, t1 = dir ? t0 - 1 : t0 + 1;
                *(LAS bf16_t*)(lds + G_QD + t0 * 272 + sk * 2) = (bf16_t)(wq & 0xffff);
                *(LAS bf16_t*)(lds + G_QD + t1 * 272 + sk * 2) = (bf16_t)(wq >> 16);
                *(LAS bf16_t*)(lds + G_KIN + t0 * 272 + sk * 2) = (bf16_t)(wk & 0xffff);
                *(LAS bf16_t*)(lds + G_KIN + t1 * 272 + sk * 2) = (bf16_t)(wk >> 16);
                ko[i >> 1] = dir ? cvt_pk(kt.y, kt.x) : cvt_pk(kt.x, kt.y);
            }
            ldsp_t kp = lds + G_KOT + sk * 136 + (dir ? 48 - 16 * seg : 16 * seg) * 2;
#pragma unroll
            for (int j = 0; j < 4; ++j) { const u32x2 w = dir ? (u32x2){ko[7 - 2 * j - 1], ko[7 - 2 * j]} : (u32x2){ko[2 * j], ko[2 * j + 1]};
                *(LAS u32x2*)(kp + 8 * j) = dir ? (u32x2){ko[7 - 2 * j], ko[7 - 2 * j - 1]} : w; }
        }
        { int fu = n + 1 < NC ? ucode : unext; const int fn = n + 1 < NC ? n + 1 : 0; asm volatile("" : "+s"(fu)); if (fu >= 0) gla_fetch(A, R, fu, fn, tid); }
        WG_BARRIER();
        if (wid < 3) {
            const int cb = dir == 0 ? (wid >= 1 ? 1 : 0) : (wid == 2 ? 1 : 0);
            const int sb = dir == 0 ? (wid == 2 ? 1 : 0) : (wid >= 1 ? 1 : 0);
            f32x16 a = f32x16{};
#pragma unroll
            for (int half = 0; half < 2; ++half) {
                bf16x8 fa[4], fb[4];
#pragma unroll
                for (int k4 = 0; k4 < 4; ++k4) { const int ks = 4 * half + k4;
                    fa[k4] = *(const LAS bf16x8*)(lds + G_QD + (32 * cb + l31) * 272 + ks * 32 + hi * 16);
                    fb[k4] = *(const LAS bf16x8*)(lds + G_KIN + (32 * sb + l31) * 272 + ks * 32 + hi * 16); }
#pragma unroll
                for (int k4 = 0; k4 < 4; ++k4) a = __builtin_amdgcn_mfma_f32_32x32x16_bf16(fa[k4], fb[k4], a, 0, 0, 0);
                __builtin_amdgcn_sched_group_barrier(0x100, 8, 0);
                __builtin_amdgcn_sched_group_barrier(0x008, 4, 0);
            }
            const int s = 32 * sb + l31;
#pragma unroll
            for (int r = 0; r < 16; ++r) { const int cc = 32 * cb + crow(r, hi); const bool keep = dir == 0 ? (cc >= s) : (cc <= s);
                *(LAS bf16_t*)(lds + G_ATT + cc * 144 + s * 2) = f2bf(keep ? a[r] : 0.f); }
        } else if (wid == 3) {
            const int cb = dir == 0 ? 0 : 1, sb = dir == 0 ? 1 : 0;
            ldsp_t p = lds + G_ATT + (32 * cb + l31) * 144 + (32 * sb + 16 * hi) * 2;
            *(LAS u32x4*)(p) = (u32x4){0u, 0u, 0u, 0u}; *(LAS u32x4*)(p + 16) = (u32x4){0u, 0u, 0u, 0u};
        }
        WG_BARRIER();
        if (wid < 4) {
            const int cb = wid & 1, vbo = wid >> 1;
            f32x16 a = f32x16{};
            {
                bf16x8 fa[4]; u32x2 vx[4], vy[4];
#pragma unroll
                for (int ks = 0; ks < 4; ++ks) {
                    fa[ks] = *(const LAS bf16x8*)(lds + G_ATT + (32 * cb + l31) * 144 + ks * 32 + hi * 16);
                    ldsp_t p = lds + G_VT + (32 * vbo + l31) * 136 + ks * 32 + hi * 16;
                    vx[ks] = *(const LAS u32x2*)(p); vy[ks] = *(const LAS u32x2*)(p + 8);
                }
#pragma unroll
                for (int ks = 0; ks < 4; ++ks) a = __builtin_amdgcn_mfma_f32_32x32x16_bf16(fa[ks], __builtin_bit_cast(bf16x8, (u32x4){vx[ks].x, vx[ks].y, vy[ks].x, vy[ks].y}), a, 0, 0, 0);
                __builtin_amdgcn_sched_group_barrier(0x100, 8, 0);
                __builtin_amdgcn_sched_group_barrier(0x008, 4, 0);
            }
            ldsp_t stp = lds + (cur ? G_ST1 : G_ST0);
#pragma unroll
            for (int half = 0; half < 2; ++half) {
                bf16x8 fa[4], fb[4];
#pragma unroll
                for (int k4 = 0; k4 < 4; ++k4) { const int ks = 4 * half + k4;
                    fa[k4] = *(const LAS bf16x8*)(lds + G_QD + (32 * cb + l31) * 272 + ks * 32 + hi * 16);
                    fb[k4] = *(const LAS bf16x8*)(stp + (32 * vbo + l31) * 272 + ks * 32 + hi * 16); }
#pragma unroll
                for (int k4 = 0; k4 < 4; ++k4) a = __builtin_amdgcn_mfma_f32_32x32x16_bf16(fa[k4], fb[k4], a, 0, 0, 0);
                __builtin_amdgcn_sched_group_barrier(0x100, 8, 0);
                __builtin_amdgcn_sched_group_barrier(0x008, 4, 0);
            }
            bf16_t* op = obuf + (size_t)row0 * 1024 + h * 128 + vhalf * 64 + 32 * vbo + l31;
#pragma unroll
            for (int r = 0; r < 16; ++r) op[(size_t)(32 * cb + crow(r, hi)) * 1024] = f2bf(a[r]);
        }
        {
#pragma unroll
            for (int r = 0; r < 16; ++r) S[r] *= *(const LAS float*)(lds + G_DEC + (32 * kb + crow(r, hi)) * 4);
            u32x2 a0[4], a1[4], b0[4], b1[4];
#pragma unroll
            for (int ks = 0; ks < 4; ++ks) {
                ldsp_t pa = lds + G_KOT + (32 * kb + l31) * 136 + ks * 32 + hi * 16;
                ldsp_t pb = lds + G_VT + (32 * vb + l31) * 136 + ks * 32 + hi * 16;
                a0[ks] = *(const LAS u32x2*)(pa); a1[ks] = *(const LAS u32x2*)(pa + 8); b0[ks] = *(const LAS u32x2*)(pb); b1[ks] = *(const LAS u32x2*)(pb + 8);
            }
#pragma unroll
            for (int ks = 0; ks < 4; ++ks)
                S = __builtin_amdgcn_mfma_f32_32x32x16_bf16(__builtin_bit_cast(bf16x8, (u32x4){a0[ks].x, a0[ks].y, a1[ks].x, a1[ks].y}), __builtin_bit_cast(bf16x8, (u32x4){b0[ks].x, b0[ks].y, b1[ks].x, b1[ks].y}), S, 0, 0, 0);
            __builtin_amdgcn_sched_group_barrier(0x100, 8, 0);
            __builtin_amdgcn_sched_group_barrier(0x008, 4, 0);
            publish(cur ^ 1);
        }
        WG_BARRIER();
        cur ^= 1;
    }
    if (!stream) {
        float* sp = A.sout + ((size_t)(b * 2 + dir) * 8 + h) * 16384;
#pragma unroll
        for (int r = 0; r < 16; ++r) sp[(32 * kb + crow(r, hi)) * 128 + vhalf * 64 + 32 * vb + l31] = S[r];
    }
}

__device__ __forceinline__ void transpose_item(const float* W, int ldw, int scol, int k0, bf16_t* WT, int K, int drow, LAS float* scr, int lane) {
    const int kr = lane >> 3, c4 = lane & 7;
    f32x4 r[8];
#pragma unroll
    for (int i = 0; i < 8; ++i) r[i] = *(const f32x4*)(W + (size_t)(k0 + 8 * i + kr) * ldw + scol + 4 * c4);
#pragma unroll
    for (int i = 0; i < 8; ++i) { LAS float* d = scr + (8 * i + kr) * 33 + 4 * c4; d[0] = r[i].x; d[1] = r[i].y; d[2] = r[i].z; d[3] = r[i].w; }
    asm volatile("s_waitcnt lgkmcnt(0)" ::: "memory");
    const int c = lane & 7;
#pragma unroll
    for (int j = 0; j < 4; ++j) { const int n = (lane >> 3) + 8 * j; const LAS float* s = scr + (8 * c) * 33 + n;
        u32x4 o; o.x = cvt_pk(s[0 * 33], s[1 * 33]); o.y = cvt_pk(s[2 * 33], s[3 * 33]); o.z = cvt_pk(s[4 * 33], s[5 * 33]); o.w = cvt_pk(s[6 * 33], s[7 * 33]);
        *(u32x4*)(WT + (size_t)(drow + n) * K + k0 + 8 * c) = o; }
    asm volatile("s_waitcnt lgkmcnt(0)" ::: "memory");
}
__device__ __forceinline__ int qkv_src_col(int c) { const int tile = c >> 8, w = c & 255; return tile * 256 + 64 * ((w >> 5) & 3) + 32 * (w >> 7); }

__device__ __forceinline__ float cond_val(const Params& P, int g, int k) { const float x = g == 0 ? P.in[10][k] : P.in[2][(g - 1) * 1024 + k]; return x / (1.f + expf(-x)); }
__device__ __forceinline__ float mod_val(const Params& P, int li, int g, int ch, int col) {
    return ((const float*)(P.ws + WS_MODP))[((size_t)li * 5 + g) * 6144 + ch * 1024 + col];
}

__device__ __forceinline__ int layer_items(int l) { return (l == 0 ? 16 * 96 : (l == 3 ? 16 * 160 : 16 * 48)) + 16 * 32 + 16 * 176 + 44 * 32; }
__device__ __forceinline__ void convert_layer_item(const Params& P, unsigned char* ws, int l, int j, LAS float* scr, int lane) {
    const int NB = l == 0 ? 96 : (l == 3 ? 160 : 48), IM = 16 * NB;
    int r = j;
    if (r < IM) { const int kbk = r / NB, nb = r % NB; const int wi = l == 0 ? 18 : (l == 1 ? 27 : (l == 2 ? 32 : 36));
        bf16_t* dst = (bf16_t*)(ws + (l == 0 ? W_QKVA : (l == 1 ? W_QKVB : (l == 2 ? W_QKVC : W_IND))));
        transpose_item(P.in[wi], NB * 32, qkv_src_col(nb * 32), kbk * 64, dst, 1024, nb * 32, scr, lane); return; } r -= IM;
    if (r < 512) { const int kbk = r / 32, nb = r % 32; const int wi = l == 0 ? 19 : (l == 1 ? 28 : (l == 2 ? 33 : 37));
        transpose_item(P.in[wi], 1024, nb * 32, kbk * 64, (bf16_t*)(ws + W_O) + (size_t)l * 1048576, 1024, nb * 32, scr, lane); return; } r -= 512;
    if (r < 16 * 176) { const int kbk = r / 176, nb = r % 176; const int c = nb * 32, tile = c >> 8, w = c & 255, bj = w >> 7, jj = w & 127;
        transpose_item(P.in[bj ? 16 : 15] + (size_t)l * 1024 * 2816, 2816, tile * 128 + jj, kbk * 64, (bf16_t*)(ws + W_FF1) + (size_t)l * 5632 * 1024, 1024, nb * 32, scr, lane); return; } r -= 16 * 176;
    { const int kbk = r / 32, nb = r % 32;
        transpose_item(P.in[17] + (size_t)l * 2816 * 1024, 1024, nb * 32, kbk * 64, (bf16_t*)(ws + W_FF2) + (size_t)l * 1024 * 2816, 2816, nb * 32, scr, lane); }
}

__device__ __forceinline__ void phase_p0a(const Params& P, ldsp_t lds, int wid_s) {
    const int tid = FRESH_TID(wid_s), lane = tid & 63, wid = wid_s;
    const int gw = blockIdx.x * 8 + wid, NGW = gridDim.x * 8;
    LAS float* scr = (LAS float*)(lds + wid * 17408);
    unsigned char* ws = P.ws;
    if (blockIdx.x < 96) {
        LAS float* shc = (LAS float*)lds; LAS float* red = (LAS float*)(lds + 20480);
        for (int i = tid; i < 5 * 1024; i += NTHREADS) shc[i] = cond_val(P, i >> 10, i & 1023);
        WG_BARRIER();
        const int li = blockIdx.x / 24, jg = blockIdx.x % 24;
        const float* W = P.in[13] + ((size_t)li * 1024 + wid * 128) * 6144 + jg * 256 + 4 * lane;
        f32x4 a[5];
#pragma unroll
        for (int g = 0; g < 5; ++g) a[g] = (f32x4){0.f, 0.f, 0.f, 0.f};
        for (int kk = 0; kk < 128; kk += 8) {
            f32x4 w[8];
#pragma unroll
            for (int i = 0; i < 8; ++i) w[i] = *(const f32x4*)(W + (size_t)(kk + i) * 6144);
#pragma unroll
            for (int i = 0; i < 8; ++i)
#pragma unroll
                for (int g = 0; g < 5; ++g) a[g] += shc[g * 1024 + wid * 128 + kk + i] * w[i];
        }
#pragma unroll
        for (int g = 0; g < 5; ++g) *(LAS f32x4*)(red + (wid * 5 + g) * 256 + 4 * lane) = a[g];
        WG_BARRIER();
        float* mp = (float*)(ws + WS_MODP);
        for (int o = tid; o < 5 * 256; o += NTHREADS) {
            const int g = o >> 8, c = o & 255; float sum = P.in[14][li * 6144 + jg * 256 + c];
#pragma unroll
            for (int w = 0; w < 8; ++w) sum += red[(w * 5 + g) * 256 + c];
            mp[((size_t)li * 5 + g) * 6144 + jg * 256 + c] = sum;
        }
        WG_BARRIER();
    }
    for (int it = gw; it < layer_items(0); it += NGW) convert_layer_item(P, ws, 0, it, scr, lane);
    if (gridDim.x != 256) for (int l = 1; l < 4; ++l) for (int it = gw; it < layer_items(l); it += NGW) convert_layer_item(P, ws, l, it, scr, lane);
    {
        const int gt = blockIdx.x * NTHREADS + tid, NGT = gridDim.x * NTHREADS;
        for (int which = 0; which < 3; ++which) {
            const int KH = which == 0 ? 16 : 4; const float* src = P.in[which == 0 ? 3 : (which == 1 ? 5 : 7)];
            bf16_t* dst = (bf16_t*)(ws + (which == 0 ? CTX_KA : (which == 1 ? CTX_KB : CTX_KC)));
            const int n8 = 4 * KH * 512 * 8;
            for (int i = gt; i < n8; i += NGT) {
                const int c8 = i & 7, key = (i >> 3) & 511, kh = (i >> 12) % KH, b = (i >> 12) / KH;
                const float* s = src + ((size_t)(b * 512 + key) * KH + kh) * 64 + c8 * 8;
                const f32x4 x = *(const f32x4*)s, y = *(const f32x4*)(s + 4);
                u32x4 o; o.x = cvt_pk(x.x, x.y); o.y = cvt_pk(x.z, x.w); o.z = cvt_pk(y.x, y.y); o.w = cvt_pk(y.z, y.w);
                *(u32x4*)(dst + (size_t)i * 8) = o;
            }
        }
    }
    {
        for (int which = 0; which < 3; ++which) {
            const int VH = which == 0 ? 8 : 4, DV = which == 0 ? 128 : 64, NDB = DV / 64; const float* src = P.in[which == 0 ? 4 : (which == 1 ? 6 : 8)];
            bf16_t* dst = (bf16_t*)(ws + (which == 0 ? CTX_VA : (which == 1 ? CTX_VB : CTX_VC)));
            const int nit = 4 * VH * 8 * NDB;
            for (int it = gw; it < nit; it += NGW) {
                const int dbk = it % NDB, kbk = (it / NDB) & 7, vh = (it / (NDB * 8)) % VH, b = it / (NDB * 8 * VH);
                for (int k8 = 0; k8 < 64; k8 += 16) { float t[16];
#pragma unroll
                    for (int q = 0; q < 16; ++q) t[q] = src[((size_t)(b * 512 + kbk * 64 + k8 + q) * VH + vh) * DV + dbk * 64 + lane];
#pragma unroll
                    for (int q = 0; q < 16; ++q) scr[(k8 + q) * 65 + lane] = t[q]; }
                asm volatile("s_waitcnt lgkmcnt(0)" ::: "memory");
#pragma unroll 16
                for (int dd = 0; dd < 64; ++dd) dst[((size_t)(b * VH + vh) * DV + dbk * 64 + dd) * 512 + kbk * 64 + lane] = f2bf(scr[lane * 65 + dd]);
                asm volatile("s_waitcnt lgkmcnt(0)" ::: "memory");
            }
        }
    }
    if (blockIdx.x == (gridDim.x > 1 ? 1 : 0)) {
        float* sv = (float*)(ws + WS_SMALL);
        if (tid < 64) { sv[SV_QNA + tid] = P.in[20][tid]; sv[SV_KNA + tid] = P.in[21][tid]; sv[SV_QNB + tid] = P.in[29][tid]; sv[SV_KNB + tid] = P.in[30][tid]; sv[SV_QNC + tid] = P.in[34][tid]; sv[SV_KNC + tid] = P.in[35][tid]; }
        if (tid < 128) { sv[SV_SUBLN + tid] = P.in[22][tid]; sv[SV_GND + tid] = P.in[38][tid]; }
        if (tid < 16) sv[SV_SINK + tid] = P.in[31][tid];
        if (wid == 0) { const float d1 = wave_sum(P.in[23][lane] * P.in[24][lane]), d2 = wave_sum(P.in[25][lane] * P.in[26][lane]);
            const float lam_init = 0.8f - 0.6f;
            if (lane == 0) { sv[SV_LAM] = expf(d1) - expf(d2) + lam_init; sv[SV_OSC] = 1.f - lam_init; } }
        for (int i = tid; i < 2048; i += NTHREADS) { const int dir = i >> 10, k = i & 1023; const float* L = P.in[39] + (size_t)dir * 4096 + k;
            const float l0 = L[0], l1 = L[1024], l2 = L[2048], l3 = L[3072]; const float mx = fmaxf(fmaxf(l0, l1), fmaxf(l2, l3));
            const float e0 = expf(l0 - mx), e1 = expf(l1 - mx), e2 = expf(l2 - mx), e3 = expf(l3 - mx);
            sv[SV_LB + i] = (e1 + e2 + e3) / (e0 + e1 + e2 + e3); }
    }
    if (blockIdx.x == 0) {
        float* rc = (float*)(ws + WS_ROPE); float* rsn = rc + 1024;
        for (int i = tid; i < 1024; i += NTHREADS) { const int idx = i >> 4, fi = i & 15; const float inv = powf(10000.f, -(float)fi / 16.f); const float ang = (float)idx * inv; rc[i] = cosf(ang); rsn[i] = sinf(ang); }
    }
}

__device__ __forceinline__ void phase_p0b(const Params& P, ldsp_t lds, int wid_s) {
    const int tid = FRESH_TID(wid_s), lane = tid & 63, wid = wid_s;
    unsigned char* ws = P.ws;
    LAS float* sh = (LAS float*)lds;
    {
        float* T = (float*)(ws + WS_TAB);
        const int gt = blockIdx.x * NTHREADS + tid, NGT = gridDim.x * NTHREADS;
        for (int i = gt; i < 4 * 5 * 4 * 1024; i += NGT) {
            const int col = i & 1023, j = (i >> 10) & 3, g = (i >> 12) % 5, li = (i >> 12) / 5;
            float v;
            if (j == 0) v = P.in[11][li * 1024 + col] * (1.f + mod_val(P, li, g, 1, col));
            else if (j == 1) v = mod_val(P, li, g, 2, col);
            else if (j == 2) v = P.in[12][li * 1024 + col] * (1.f + mod_val(P, li, g, 4, col));
            else v = mod_val(P, li, g, 5, col);
            T[i] = v;
        }
    }
    {
        float* BIAS = (float*)(ws + WS_BIAS);
        LAS float* red = (LAS float*)(lds + 20480);
        for (int u = blockIdx.x; u < 132; u += gridDim.x) {
            int seg, tile;
            if (u < 12) { seg = 0; tile = u; } else if (u < 18) { seg = 2; tile = u - 12; } else if (u < 24) { seg = 4; tile = u - 18; } else if (u < 44) { seg = 6; tile = u - 24; }
            else { const int q = u - 44; seg = 2 * (q / 22) + 1; tile = q % 22; }
            const int li = seg >> 1, ffn = seg & 1;
            WG_BARRIER();
            for (int i = tid; i < 5 * 1024; i += NTHREADS) sh[i] = mod_val(P, li, i >> 10, ffn ? 3 : 0, i & 1023);
            WG_BARRIER();
            const int c = 4 * lane, bj = c >> 7;
            const float* W; int ldw;
            if (ffn) { W = P.in[bj ? 16 : 15] + (size_t)li * 1024 * 2816 + tile * 128 + (c & 127); ldw = 2816; }
            else { ldw = li == 0 ? 3072 : (li == 3 ? 5120 : 1536); W = P.in[li == 0 ? 18 : (li == 1 ? 27 : (li == 2 ? 32 : 36))] + tile * 256 + 64 * ((c >> 5) & 3) + 32 * bj + (c & 31); }
            W += (size_t)(wid * 128) * ldw;
            f32x4 a[5];
#pragma unroll
            for (int g = 0; g < 5; ++g) a[g] = (f32x4){0.f, 0.f, 0.f, 0.f};
            for (int kk = 0; kk < 128; kk += 8) {
                f32x4 w[8];
#pragma unroll
                for (int i = 0; i < 8; ++i) w[i] = *(const f32x4*)(W + (size_t)(kk + i) * ldw);
#pragma unroll
                for (int i = 0; i < 8; ++i)
#pragma unroll
                    for (int g = 0; g < 5; ++g) a[g] += sh[g * 1024 + wid * 128 + kk + i] * w[i];
            }
#pragma unroll
            for (int g = 0; g < 5; ++g) *(LAS f32x4*)(red + (wid * 5 + g) * 256 + 4 * lane) = a[g];
            WG_BARRIER();
            for (int o = tid; o < 5 * 256; o += NTHREADS) {
                const int g = o >> 8, cc = o & 255; float sum = 0.f;
#pragma unroll
                for (int w = 0; w < 8; ++w) sum += red[(w * 5 + g) * 256 + cc];
                BIAS[((size_t)seg * 5 + g) * 5632 + tile * 256 + cc] = sum;
            }
        }
        WG_BARRIER();
    }
    {
        for (int i = tid; i < 5 * 1024; i += NTHREADS) sh[i] = P.in[11][i & 1023] * (1.f + mod_val(P, 0, i >> 10, 1, i & 1023));
        WG_BARRIER();
        bf16_t* XS = (bf16_t*)(ws + WS_XS); float* RSS = (float*)(ws + WS_RSS);
        const int gw = blockIdx.x * 8 + wid, NGW = gridDim.x * 8;
        for (int row = gw; row < MROWS; row += NGW) {
            const float* xr = row < MP ? P.in[0] + (size_t)row * 1024 : P.in[1] + (size_t)(row - MP) * 1024;
            const int g = row < MP ? 0 : 1 + ((row - MP) >> 11);
            float ss = 0.f;
#pragma unroll
            for (int j = 0; j < 4; ++j) { const f32x4 x = *(const f32x4*)(xr + 256 * j + 4 * lane); ss += (x.x * x.x + x.y * x.y) + (x.z * x.z + x.w * x.w);
                const f32x4 c = *(const LAS f32x4*)(sh + g * 1024 + 256 * j + 4 * lane); const f32x4 y = x * c;
                u32x2 w; w.x = cvt_pk(y.x, y.y); w.y = cvt_pk(y.z, y.w); *(u32x2*)(XS + (size_t)row * 1024 + 256 * j + 4 * lane) = w; }
            ss = wave_sum(ss);
            if (lane == 0) *(f32x4*)(RSS + (size_t)row * 4) = (f32x4){ss, 0.f, 0.f, 0.f};
        }
        WG_BARRIER();
    }
}

__device__ __forceinline__ void phase_gnorm(const Params& P, int wid_s) {
    const int tid = FRESH_TID(wid_s), lane = tid & 63, wid = wid_s;
    const int gw = blockIdx.x * 8 + wid, NGW = gridDim.x * 8;
    const bf16_t* of = (const bf16_t*)(P.ws + WS_XS); const bf16_t* ob = (const bf16_t*)(P.ws + B_DOB); bf16_t* gb = (bf16_t*)(P.ws + B_DG);
    const float* gn = (const float*)(P.ws + WS_SMALL) + SV_GND;
    float gnv[16];
#pragma unroll
    for (int i = 0; i < 16; ++i) gnv[i] = gn[(lane & 7) * 16 + i];
    for (int row = gw; row < MROWS; row += NGW) {
        const size_t off = (size_t)row * 1024 + lane * 16;
        const u32x4 a0 = *(const u32x4*)(of + off), a1 = *(const u32x4*)(of + off + 8), b0 = *(const u32x4*)(ob + off), b1 = *(const u32x4*)(ob + off + 8), g0 = *(const u32x4*)(gb + off), g1 = *(const u32x4*)(gb + off + 8);
        float o[16], gg[16];
#pragma unroll
        for (int i = 0; i < 4; ++i) {
            o[2 * i] = bf2f(a0[i] & 0xffff) + bf2f(b0[i] & 0xffff); o[2 * i + 1] = bf2f(a0[i] >> 16) + bf2f(b0[i] >> 16);
            o[8 + 2 * i] = bf2f(a1[i] & 0xffff) + bf2f(b1[i] & 0xffff); o[8 + 2 * i + 1] = bf2f(a1[i] >> 16) + bf2f(b1[i] >> 16);
            gg[2 * i] = bf2f(g0[i] & 0xffff); gg[2 * i + 1] = bf2f(g0[i] >> 16); gg[8 + 2 * i] = bf2f(g1[i] & 0xffff); gg[8 + 2 * i + 1] = bf2f(g1[i] >> 16);
        }
        float ss = 0.f;
#pragma unroll
        for (int i = 0; i < 16; ++i) ss += o[i] * o[i];
        ss += __shfl_xor(ss, 1); ss += __shfl_xor(ss, 2); ss += __shfl_xor(ss, 4);
        const float r = rsqrtf(ss * (1.f / 128.f) + EPS);
        u32x4 w0, w1;
#pragma unroll
        for (int i = 0; i < 4; ++i) {
            w0[i] = cvt_pk(o[2 * i] * r * gnv[2 * i] * silu_f(gg[2 * i]), o[2 * i + 1] * r * gnv[2 * i + 1] * silu_f(gg[2 * i + 1]));
            w1[i] = cvt_pk(o[8 + 2 * i] * r * gnv[8 + 2 * i] * silu_f(gg[8 + 2 * i]), o[8 + 2 * i + 1] * r * gnv[8 + 2 * i + 1] * silu_f(gg[8 + 2 * i + 1]));
        }
        *(u32x4*)(gb + off) = w0; *(u32x4*)(gb + off + 8) = w1;
    }
}

typedef __attribute__((address_space(1))) unsigned gu32;
#define XB_TMO      128
#define XB_XCNT(j)  (256  + 64 * (j))
#define XB_XSUB(j)  (1280 + 64 * (j))
#define XB_XGEN(j)  (2304 + 64 * (j))
#define XB_TOP      3328
#define XB_TOPGEN   3392
#define XCD_BAR_WORDS 3456
#define XB_SPIN_CAP (1u << 18)

__device__ __forceinline__ unsigned xb_ld(unsigned* p)              { return __hip_atomic_load(p, __ATOMIC_RELAXED, __HIP_MEMORY_SCOPE_AGENT); }
__device__ __forceinline__ unsigned xb_add(unsigned* p, unsigned v) { return __hip_atomic_fetch_add(p, v, __ATOMIC_RELAXED, __HIP_MEMORY_SCOPE_AGENT); }
__device__ __forceinline__ unsigned xb_xcc_id() { return (unsigned)__builtin_amdgcn_s_getreg((3 << 11) | 20) & 0xFu; }
#define XB_SPIN(cond, bar) do { unsigned _sp = 0; while (cond) { __builtin_amdgcn_s_sleep(1); \
    if ((++_sp & 255u) == 0u) { if (xb_ld(&(bar)[XB_TMO])) break; if (_sp > XB_SPIN_CAP) { atomicAdd(&(bar)[XB_TMO], 1u); break; } } } } while (0)

struct XcdBarrier {
    unsigned* bar; unsigned x;
    volatile LAS unsigned* st;
};

__device__ __forceinline__ XcdBarrier xcd_barrier_post(unsigned* bar, volatile LAS unsigned* st, bool t0) {
    XcdBarrier b; b.bar = bar; b.x = xb_xcc_id(); b.st = st;
    if (t0) (void)xb_add(&bar[XB_XCNT(b.x)], 1u);
    return b;
}
__device__ __forceinline__ void xcd_barrier_complete(unsigned* bar, unsigned x, unsigned& nloc, unsigned& nx) {
    const unsigned G = gridDim.x * gridDim.y * gridDim.z;
    unsigned sum, cnt, mine, sp = 0u;
    for (;;) {
        sum = 0u; cnt = 0u; mine = 0u;
#pragma unroll
        for (unsigned j = 0; j < 16; ++j) { const unsigned c = xb_ld(&bar[XB_XCNT(j)]); sum += c; cnt += (c > 0u) ? 1u : 0u; mine = (j == x) ? c : mine; }
        if (sum == G) break;
        __builtin_amdgcn_s_sleep(1);
        if ((++sp & 255u) == 0u) { if (xb_ld(&bar[XB_TMO])) break; if (sp > XB_SPIN_CAP) { atomicAdd(&bar[XB_TMO], 1u); break; } }
    }
    nloc = mine > 0u ? mine : 1u; nx = cnt > 0u ? cnt : 1u;
}

__device__ __forceinline__ void xcd_census(const XcdBarrier& b) {
    OPAQUE_PTR(unsigned*, bar, b.bar);
    unsigned cnt = 0u, mine = 0u;
#pragma unroll 1
    for (unsigned j = 0; j < 16; ++j) { const unsigned c = xb_ld(&bar[256 + 64 * j]); cnt += (c > 0u) ? 1u : 0u; mine = (j == b.x) ? c : mine; }
    b.st[0] = mine > 0u ? mine : 1u; b.st[1] = cnt > 0u ? cnt : 1u;
}
__device__ __forceinline__ void xcd_barrier(const XcdBarrier& b, int wid_s) {
    asm volatile("s_waitcnt vmcnt(0)" ::: "memory");
    __syncthreads();
    if (wid_s == 0 && FRESH_TID(0) == 0) {
        OPAQUE_PTR(unsigned*, bar, b.bar);
        __builtin_amdgcn_s_waitcnt(0);
        const unsigned nloc = b.st[0], nx = b.st[1];
        const unsigned old = xb_add(&bar[XB_XSUB(b.x)], 1u);
        const unsigned gen = old / nloc;
        if (old + 1u == (gen + 1u) * nloc) {
            __builtin_amdgcn_fence(__ATOMIC_RELEASE, "agent");
            asm volatile("s_waitcnt vmcnt(0)" ::: "memory");
            const unsigned og = xb_add(&bar[XB_TOP], 1u);
            const unsigned tg = og / nx;
            if (og + 1u == (tg + 1u) * nx) xb_add(&bar[XB_TOPGEN], 1u);
            else XB_SPIN(xb_ld(&bar[XB_TOPGEN]) == tg, bar);
            __builtin_amdgcn_fence(__ATOMIC_ACQUIRE, "agent");
            xb_add(&bar[XB_XGEN(b.x)], 1u);
            asm volatile("s_waitcnt vmcnt(0)" ::: "memory");
        } else {
            XB_SPIN(xb_ld(&bar[XB_XGEN(b.x)]) == gen, bar);
            __builtin_amdgcn_fence(__ATOMIC_ACQUIRE, "agent");
            asm volatile("s_waitcnt vmcnt(0)" ::: "memory");
        }
    }
    __syncthreads();
}

constexpr int NPHASES = 26;
__global__ void __launch_bounds__(NTHREADS, 2) mega_fwd(Params P) {
    extern __shared__ __attribute__((aligned(16))) unsigned char lds_raw[];
    ldsp_t lds = (ldsp_t)lds_raw;
    cg::grid_group grid = cg::this_grid();
    const int lo = P.ph_lo, hi = P.ph_hi;
    bool started = false;
    volatile LAS unsigned* bst = (volatile LAS unsigned*)(lds + (LDS_BYTES - 64));
    const int wid_s = __builtin_amdgcn_readfirstlane((int)threadIdx.x >> 6);
    if (wid_s == 0 && FRESH_TID(0) < 2) bst[FRESH_TID(0)] = 0u;
    __syncthreads();
    XcdBarrier xbar = xcd_barrier_post((unsigned*)P.ws, bst, wid_s == 0 && FRESH_TID(0) == 0);
    int nseam = 0;
#define PHASE(id) if (lo <= (id) && (id) < hi)
#define SEAM() do { if (started) { if (nseam == 0) { grid.sync(); if (wid_s == 0 && FRESH_TID(0) == 0) xcd_census(xbar); } else xcd_barrier(xbar, wid_s); ++nseam; } started = true; } while (0)

    PHASE(0) { SEAM(); phase_p0a(P, lds, wid_s); }
    PHASE(1) { SEAM(); phase_p0b(P, lds, wid_s); }

    for (int li = 0; li < 4; ++li) {
        const int pb = 2 + 6 * li;
        PHASE(pb + 0) {
            SEAM();
            {
            OPAQUE_PTR(unsigned char*, ws, P.ws); OPAQUE_PTR(float*, outp, P.out);
            if (li == 0) {
                pg8::Gemm g{(const bf16_t*)(ws + WS_XS), (const bf16_t*)(ws + W_QKVA), MROWS, 3072, 1024}; pg8::StaticOrder S; S.init(MROWS, 3072, gridDim.x, (int)blockIdx.x);
                EpiQKV<0> E{ws, outp, li};
                pg8::gemm_phase<EpiQKV<0>, pg8::StaticOrder, true, true>(lds, g, S, E, wid_s);
            } else if (li == 1 || li == 2) {
                pg8::Gemm g{(const bf16_t*)(ws + WS_XS), (const bf16_t*)(ws + (li == 1 ? W_QKVB : W_QKVC)), MROWS, 1536, 1024}; pg8::StaticOrder S; S.init(MROWS, 1536, gridDim.x, (int)blockIdx.x);
                EpiQKV<1> E{ws, outp, li};
                pg8::gemm_phase<EpiQKV<1>, pg8::StaticOrder, true, true>(lds, g, S, E, wid_s);
            } else {
                pg8::Gemm g{(const bf16_t*)(ws + WS_XS), (const bf16_t*)(ws + W_IND), MROWS, 5120, 1024}; pg8::StaticOrder S; S.init(MROWS, 5120, gridDim.x, (int)blockIdx.x);
                EpiInD E{ws};
                pg8::gemm_phase<EpiInD, pg8::StaticOrder, true, true>(lds, g, S, E, wid_s);
            }
            }
        }
        PHASE(pb + 1) {
            SEAM();
            {
            OPAQUE_PTR(unsigned char*, ws, P.ws); OPAQUE_PTR(float*, outp, P.out);
            const float* sv = (const float*)(ws + WS_SMALL);
            int gdx = (int)gridDim.x, bix = (int)blockIdx.x; LAUNDER_S(gdx); LAUNDER_S(bix);
            if (li < 3) {
                AttnArgs A;
                A.Q = (const bf16_t*)(ws + B_Q); A.Kp = (const bf16_t*)(ws + B_K); A.Ks = (const bf16_t*)(ws + B_K + 16 * MiB); A.Vtp = (const bf16_t*)(ws + B_V); A.Vts = (const bf16_t*)(ws + B_V + 16 * MiB);
                A.cK = (const bf16_t*)(ws + (li == 0 ? CTX_KA : (li == 1 ? CTX_KB : CTX_KC))); A.cVt = (const bf16_t*)(ws + (li == 0 ? CTX_VA : (li == 1 ? CTX_VB : CTX_VC)));
                A.O = (bf16_t*)(ws + B_O); A.sink = li == 1 ? sv + SV_SINK : nullptr; A.window = li == 1 ? 1 : 0; A.lam = sv[SV_LAM]; A.osc = sv[SV_OSC]; A.subln = sv + SV_SUBLN;
                const int xcd = bix & 7, idx = bix >> 3, nrd = (gdx == 256) ? 4 : 0;
                if (li == 0) {
                    for (int r = 0; r < nrd; ++r) {
                        if (r < 2) { const int pair = 16 * r + 2 * xcd + (idx >> 4); attn_unit_rs<0>(lds, A, 1, pair >> 3, pair & 7, idx & 15, wid_s); }
                        else { const int pair = 128 * (r - 2) + 16 * xcd + (idx >> 1); attn_unit_rs<0>(lds, A, 0, pair >> 3, pair & 7, idx & 1, wid_s); }
                    }
                    if (nrd == 0) for (int u = bix; u < 1024; u += gdx) {
                        if (u < 512) attn_unit_rs<0>(lds, A, 1, u >> 7, (u >> 4) & 7, u & 15, wid_s);
                        else { const int v = u - 512; attn_unit_rs<0>(lds, A, 0, v >> 4, (v >> 1) & 7, v & 1, wid_s); }
                    }
                } else {
                    for (int r = 0; r < nrd; ++r) {
                        if (r < 2) { const int pair = 8 * r + xcd; attn_unit_rs<1>(lds, A, 1, pair >> 2, pair & 3, idx, wid_s); }
                        else { const int pair = 64 * (r - 2) + 8 * xcd + (idx >> 2); attn_unit_rs<1>(lds, A, 0, pair >> 2, pair & 3, idx & 3, wid_s); }
                    }
                    if (nrd == 0) for (int u = bix; u < 1024; u += gdx) {
                        if (u < 512) attn_unit_rs<1>(lds, A, 1, u >> 7, (u >> 5) & 3, u & 31, wid_s);
                        else { const int v = u - 512; attn_unit_rs<1>(lds, A, 0, v >> 4, (v >> 2) & 3, v & 3, wid_s); }
                    }
                }
            } else {
                GlaArgs A{(const bf16_t*)(ws + B_DQ), (const bf16_t*)(ws + B_DV), (const _Float16*)(ws + B_DLF), (bf16_t*)(ws + WS_XS), (bf16_t*)(ws + B_DOB), P.in[9], outp + OUT_SD};
                GlaRegs R;
                const bool bal = gdx == 256; const int nun = bal ? (bix < 128 ? 2 : 7) : (1152 - bix + gdx - 1) / gdx;
                auto unit_at = [&](int k) { return bal ? (bix < 128 ? (k == 0 ? bix : 1024 + bix) : bix + 128 * k) : bix + k * gdx; };
                gla_fetch(A, R, unit_at(0), 0, FRESH_TID(wid_s));
                for (int k = 0; k < nun; ++k) gla_unit(lds, A, unit_at(k), k + 1 < nun ? unit_at(k + 1) : -1, R, wid_s);
            }
            }
        }
        PHASE(pb + 2) { if (li == 3) { SEAM(); phase_gnorm(P, wid_s); } }
        PHASE(pb + 3) {
            SEAM();
            OPAQUE_PTR(unsigned char*, ws, P.ws); OPAQUE_PTR(float*, outp, P.out);
            pg8::Gemm g{(const bf16_t*)(ws + (li == 3 ? B_DG : B_O)), (const bf16_t*)(ws + W_O) + (size_t)li * 1048576, MROWS, 1024, 1024}; pg8::StaticOrder S; S.init(MROWS, 1024, gridDim.x, (int)blockIdx.x);
            EpiRes E{P.in[0], P.in[1], ws, outp, li, 0};
            pg8::gemm_phase<EpiRes, pg8::StaticOrder, false, true>(lds, g, S, E, wid_s);
        }
        PHASE(pb + 4) {
            SEAM();
            OPAQUE_PTR(unsigned char*, ws, P.ws);
            pg8::Gemm g{(const bf16_t*)(ws + WS_XS), (const bf16_t*)(ws + W_FF1) + (size_t)li * 5632 * 1024, MROWS, 5632, 1024}; pg8::StaticOrder S; S.init(MROWS, 5632, gridDim.x, (int)blockIdx.x);
            stage_epi_rb(lds, S, (const float*)(ws + WS_RSS) + (size_t)(2 * li + 1) * MROWS * 4, (const float*)(ws + WS_BIAS) + (size_t)(2 * li + 1) * 5 * 5632, 5632, wid_s);
            EpiSwiGLU E{ws, li, lds};
            pg8::gemm_phase<EpiSwiGLU, pg8::StaticOrder, true, true>(lds, g, S, E, wid_s);
            int gdc = (int)gridDim.x, bic = (int)blockIdx.x; LAUNDER_S(gdc); LAUNDER_S(bic);
            if (li < 3 && gdc == 256 && bic >= 128) {
                const int tid_c = FRESH_TID(wid_s); const int lane = tid_c & 63, wv = wid_s, gwv = (bic - 128) * 8 + wv;
                LAS float* scr = (LAS float*)(lds + wv * 17408);
                const int nit = layer_items(li + 1);
                for (int it = gwv; it < nit; it += 1024) convert_layer_item(P, ws, li + 1, it, scr, lane);
            }
        }
        PHASE(pb + 5) {
            SEAM();
            OPAQUE_PTR(unsigned char*, ws, P.ws); OPAQUE_PTR(float*, outp, P.out);
            pg8::Gemm g{(const bf16_t*)(ws + B_H), (const bf16_t*)(ws + W_FF2) + (size_t)li * 1024 * 2816, MROWS, 1024, DFF}; pg8::StaticOrder S; S.init(MROWS, 1024, gridDim.x, (int)blockIdx.x);
            EpiRes E{P.in[0], P.in[1], ws, outp, li, 1};
            pg8::gemm_phase<EpiRes, pg8::StaticOrder, false, true, 32>(lds, g, S, E, wid_s);
        }
    }
#undef PHASE
#undef SEAM
}


#ifndef N_LAUNCH_MODE
#define N_LAUNCH_MODE 1
#endif
#ifndef MAX_PHASE
#define MAX_PHASE NPHASES
#endif
extern "C" void kernel_launch(void* const* d_in, const int* in_sizes, int n_in, void* d_out, int out_size, void* d_ws, size_t ws_size, hipStream_t stream) {
    static int grid = 0;
    if (grid == 0) {
        int dev = 0, cus = 0, per_cu = 0;
        (void)hipGetDevice(&dev);
        (void)hipDeviceGetAttribute(&cus, hipDeviceAttributeMultiprocessorCount, dev);
        (void)hipFuncSetAttribute((const void*)mega_fwd, hipFuncAttributeMaxDynamicSharedMemorySize, LDS_BYTES);
        (void)hipOccupancyMaxActiveBlocksPerMultiprocessor(&per_cu, (const void*)mega_fwd, NTHREADS, LDS_BYTES);
        (void)hipGetLastError();
        grid = cus * (per_cu < 1 ? 1 : per_cu);
        if (grid != 256) fprintf(stderr, "kernel_launch: grid %d (cus %d per_cu %d): this kernel is built for 256 resident workgroups\n", grid, cus, per_cu);
        if (n_in != 40 || ws_size < WS_END) fprintf(stderr, "kernel_launch: n_in %d ws %zu (need %zu)\n", n_in, ws_size, (size_t)WS_END);
        if (grid > 256) grid = 256;
    }
    Params p{};
    for (int i = 0; i < 40; ++i) p.in[i] = (const float*)d_in[i];
    p.out = (float*)d_out; p.ws = (unsigned char*)d_ws;
#if N_LAUNCH_MODE == 1
    p.ph_lo = 0; p.ph_hi = NPHASES;
    (void)hipMemsetAsync(d_ws, 0, 16384, stream);
    void* args[] = {&p};
    hipError_t e = hipLaunchCooperativeKernel((const void*)mega_fwd, dim3(grid), dim3(NTHREADS), args, LDS_BYTES, stream);
    if (e != hipSuccess) fprintf(stderr, "cooperative launch failed: %s (grid %d)\n", hipGetErrorString(e), grid);
#else
    for (int ph = 0; ph < MAX_PHASE; ++ph) {
        const int li = ph >= 2 ? (ph - 2) / 6 : -1, sub = ph >= 2 ? (ph - 2) % 6 : -1;
        if (sub == 2 && li != 3) continue;
        p.ph_lo = ph; p.ph_hi = ph + 1;
        hipLaunchKernelGGL(mega_fwd, dim3(grid), dim3(NTHREADS), LDS_BYTES, stream, p);
    }
#endif
}
```

```cpp
#include <hip/hip_runtime.h>
#include <hip/hip_cooperative_groups.h>
#include <cstdio>
#include <cstdint>
namespace cg = cooperative_groups;
#define N_LAUNCH_MODE 1
namespace pg8 {
#define PG8_LAS __attribute__((address_space(3)))
typedef unsigned short bf16_t;
typedef short bf16x8 __attribute__((ext_vector_type(8)));
typedef float f32x4 __attribute__((ext_vector_type(4)));
typedef unsigned u32x4 __attribute__((ext_vector_type(4)));
constexpr int BM = 256, BK = 64, HALF = 128, HTB = HALF * BK * 2  , STAGE_BYTES = 8 * HTB, NXCD = 8, WGM = 8;

__host__ __device__ __forceinline__ int lds_byte(int r, int c) { const int st = (r >> 4) * 2 + (c >> 5), rr = r & 15, cc = c & 31, ob = rr * 64 + cc * 2; return st * 1024 + (ob ^ (((ob >> 9) & 1) << 5)); }
__host__ __device__ __forceinline__ void stage_rc(int b, int& R, int& C) { const int st = b / 1024, sb = b % 1024, swz = sb ^ (((sb >> 9) & 1) << 5); R = (st >> 1) * 16 + swz / 64; C = (st & 1) * 32 + (swz % 64) / 2; }
__host__ __device__ __forceinline__ int perm32(int rho) { const int n = rho >> 4, i = rho & 15; return 8 * (i >> 2) + 4 * n + (i & 3); }

struct Unit { int pm, pn, idx, half; };
struct Gemm { const bf16_t* A; const bf16_t* Bt; int M, N, K; };

struct StaticOrder {
    int nM, nN, nwg, G, c;
    __host__ __device__ void init(int M, int N, int G_, int c_) { nM = M / BM; nN = N / BM; nwg = nM * nN; G = G_; c = c_; }
    __host__ __device__ void decode(long L, Unit& u) const {
        int wgid = (int)L; { const int q = nwg / NXCD, r = nwg % NXCD, xcd = wgid % NXCD, off = wgid / NXCD; wgid = (xcd < r ? xcd * (q + 1) : r * (q + 1) + (xcd - r) * q) + off; }
        const int nig = WGM * nN, gid = wgid / nig, fm = gid * WGM, gsz = (nM - fm) < WGM ? (nM - fm) : WGM;
        u.pm = fm + ((wgid % nig) % gsz); u.pn = (wgid % nig) / gsz; u.half = -1;
        if (nM == 64) { const int x_ = u.pm >> 3, j_ = u.pm & 7; u.pm = j_ < 4 ? 4 * x_ + j_ : 32 + 4 * x_ + (j_ - 4); }
    }
    __host__ __device__ bool next(int i, Unit& u) const {
        const long L = (long)i * G + c; if (L >= nwg) return false;
        decode(L, u); u.idx = i; return true;
    }
    __device__ __forceinline__ void a_ready(const Unit&) const {}
    __device__ __forceinline__ void done(const Unit&) const {}
};
struct FirstOrder : StaticOrder { __device__ bool next(int i, Unit& u) const { return i == 0 && StaticOrder::next(0, u); } };
struct HalfOrder : StaticOrder {
    __device__ bool next(int i, Unit& u) const {
        if (i != 0) return false;
        const int x = c & 7, ii = c >> 3; decode((long)(32 + (ii >> 1)) * 8 + x, u); u.idx = 0; u.half = ii & 1; return true;
    }
};
template <class Epi, class Sched, bool ALIGN_EPI = false, bool SP2 = false, int KROT = 0, bool HALFU = false>
__device__ __forceinline__ void gemm_phase(PG8_LAS unsigned char* lds, const Gemm g, const Sched& S, const Epi& E, int wid_s) {
    unsigned msk_o = ~0u; asm volatile("" : "+s"(msk_o)); int tid_l = (int)__builtin_amdgcn_mbcnt_hi(msk_o, __builtin_amdgcn_mbcnt_lo(msk_o, 0u)); tid_l += wid_s * 64;
    int wid_o = wid_s; asm volatile("" : "+s"(wid_o));
    const int tid = tid_l, wid = wid_o, lane = tid & 63, wr = wid >> 2, wc = wid & 3, fr = lane & 15, fq = lane >> 4;
    const int K = g.K, nt = K / BK;
    unsigned voffA[2], voffB[2];
#pragma unroll
    for (int i = 0; i < 2; ++i) { int R, C; stage_rc(tid * 16 + i * 8192, R, C); const int Rb = Epi::PERM ? ((R & ~31) + perm32(R & 31)) : R;
        voffA[i] = (unsigned)(R * K + C) * 2u; voffB[i] = (unsigned)(Rb * K + C) * 2u; }
    const size_t kstep = (size_t)(BK * 2);
    const size_t hstep = (size_t)HALF * K * 2;
    const size_t tstep = 2 * hstep;
    const unsigned ldsw = (unsigned)wid * 1024u;
    const int aoff = lds_byte(wr * 64 + fr, fq * 8), boff = lds_byte(wc * 32 + fr, fq * 8);
#define PG8_SA(b, h) (((b) * 2 + (h)) * HTB)
#define PG8_SB(b, h) ((4 + (b) * 2 + (h)) * HTB)
#define PG8_STAGE(bufoff, gbase, voff) do { _Pragma("unroll") for (int _i = 0; _i < 2; ++_i) \
        __builtin_amdgcn_global_load_lds((const unsigned*)((const char*)(gbase) + (voff)[_i]), (PG8_LAS unsigned*)(lds + (bufoff) + ldsw + _i * 8192), 16, 0, 0); } while (0)
#define PG8_LDA(dst, b, h) do { _Pragma("unroll") for (int m = 0; m < 4; ++m) _Pragma("unroll") for (int k = 0; k < 2; ++k) dst[m][k] = *(const PG8_LAS bf16x8*)(lds + PG8_SA(b, h) + aoff + m * 2048 + k * 1024); } while (0)
#define PG8_LDB(dst, b, h) do { _Pragma("unroll") for (int n = 0; n < 2; ++n) _Pragma("unroll") for (int k = 0; k < 2; ++k) dst[n][k] = *(const PG8_LAS bf16x8*)(lds + PG8_SB(b, h) + boff + n * 2048 + k * 1024); } while (0)
#define PG8_MMA(ai, bj, At, Bt) do { __builtin_amdgcn_s_setprio(1); _Pragma("unroll") for (int m = 0; m < 4; ++m) _Pragma("unroll") for (int n = 0; n < 2; ++n) _Pragma("unroll") for (int k = 0; k < 2; ++k) \
        acc[ai][bj][m][n] = __builtin_amdgcn_mfma_f32_16x16x32_bf16(Bt[n][k], At[m][k], acc[ai][bj][m][n], 0, 0, 0); __builtin_amdgcn_s_setprio(0); } while (0)
#define PG8_WAIT_V(n) asm volatile("s_waitcnt vmcnt(" #n ")" ::: "memory")
#define PG8_WAIT_L(n) asm volatile("s_waitcnt lgkmcnt(" #n ")" ::: "memory")
#define PG8_BAR __builtin_amdgcn_s_barrier()
#define PG8_SCHED __builtin_amdgcn_sched_barrier(0)
    Unit cur, nxt; int ui = 0;
    if (!S.next(0, cur)) return;
    f32x4 acc[2][2][4][2];
#pragma unroll
    for (int a = 0; a < 2; ++a)
#pragma unroll
        for (int b = 0; b < 2; ++b)
#pragma unroll
            for (int m = 0; m < 4; ++m)
#pragma unroll
                for (int n = 0; n < 2; ++n) acc[a][b][m][n] = (f32x4){0.f, 0.f, 0.f, 0.f};
    bf16x8 At[4][2], B0[2][2], B1[2][2];
    const char* cA = (const char*)g.A + (size_t)cur.pm * tstep + (cur.half > 0 ? hstep : (size_t)0); const char* cB = (const char*)g.Bt + (size_t)cur.pn * tstep;
    if constexpr (KROT != 0) { cA += (size_t)KROT * kstep; cB += (size_t)KROT * kstep; }
    S.a_ready(cur);
    if constexpr (SP2) {
        PG8_STAGE(PG8_SB(0, 0), cB, voffB); PG8_STAGE(PG8_SB(0, 1), cB + hstep, voffB); PG8_STAGE(PG8_SA(0, 0), cA, voffA); PG8_STAGE(PG8_SA(0, 1), cA + hstep, voffA);
        if (wr == 1) PG8_BAR;
        PG8_WAIT_V(2); PG8_BAR;
        PG8_STAGE(PG8_SB(1, 0), cB + kstep, voffB); PG8_STAGE(PG8_SA(1, 0), cA + kstep, voffA); PG8_STAGE(PG8_SB(1, 1), cB + hstep + kstep, voffB);
        PG8_WAIT_V(6); PG8_BAR;
    } else {
        PG8_STAGE(PG8_SB(0, 0), cB, voffB); PG8_STAGE(PG8_SA(0, 0), cA, voffA); PG8_STAGE(PG8_SB(0, 1), cB + hstep, voffB); PG8_STAGE(PG8_SA(0, 1), cA + hstep, voffA);
        if (wr == 1) PG8_BAR;
        PG8_WAIT_V(4); PG8_BAR;
        PG8_STAGE(PG8_SB(1, 0), cB + kstep, voffB); PG8_STAGE(PG8_SA(1, 0), cA + kstep, voffA); PG8_STAGE(PG8_SB(1, 1), cB + hstep + kstep, voffB);
        PG8_WAIT_V(6); PG8_BAR;
    }
    for (;;) {
        const bool has_next = S.next(ui + 1, nxt);
        const char* nA = has_next ? (const char*)g.A + (size_t)nxt.pm * tstep + (nxt.half > 0 ? hstep : (size_t)0) : cA; const char* nB = has_next ? (const char*)g.Bt + (size_t)nxt.pn * tstep : cB;
        for (int t = 0; t < nt; t += 2) {
            const bool last = (t == nt - 2);
            const char* a1 = cA + (size_t)(t + 1) * kstep;
            if constexpr (KROT != 0) { if (t + 2 + KROT == nt) { cA -= (size_t)nt * kstep; cB -= (size_t)nt * kstep; } }
            const char* a2 = last ? nA : cA + (size_t)(t + 2) * kstep; const char* b2 = last ? nB : cB + (size_t)(t + 2) * kstep;
            const char* a3 = a2 + kstep; const char* b3 = b2 + kstep;
            if (last && has_next) S.a_ready(nxt);
            if constexpr (SP2) {
            PG8_LDB(B0, 0, 0); PG8_LDB(B1, 0, 1); PG8_SCHED; PG8_LDA(At, 0, 0); PG8_STAGE(PG8_SA(1, 1), a1 + hstep, voffA);
            PG8_WAIT_V(8); PG8_WAIT_L(0); PG8_BAR; PG8_MMA(0, 0, At, B0); PG8_MMA(0, 1, At, B1); PG8_BAR; PG8_SCHED;
            if constexpr (!HALFU) PG8_LDA(At, 0, 1); PG8_STAGE(PG8_SB(0, 0), b2, voffB); PG8_STAGE(PG8_SB(0, 1), b2 + hstep, voffB); PG8_STAGE(PG8_SA(0, 0), a2, voffA);
            PG8_WAIT_V(8); PG8_WAIT_L(0); PG8_BAR; if constexpr (!HALFU) { PG8_MMA(1, 0, At, B0); PG8_MMA(1, 1, At, B1); } PG8_BAR; PG8_SCHED;
            PG8_LDB(B0, 1, 0); PG8_LDB(B1, 1, 1); PG8_SCHED; PG8_LDA(At, 1, 0); PG8_STAGE(PG8_SA(0, 1), a2 + hstep, voffA);
            PG8_WAIT_V(8); PG8_WAIT_L(0); PG8_BAR; PG8_MMA(0, 0, At, B0); PG8_MMA(0, 1, At, B1); PG8_BAR; PG8_SCHED;
            if constexpr (!HALFU) PG8_LDA(At, 1, 1); PG8_STAGE(PG8_SB(1, 0), b3, voffB); PG8_STAGE(PG8_SB(1, 1), b3 + hstep, voffB); PG8_STAGE(PG8_SA(1, 0), a3, voffA);
            PG8_WAIT_V(8); PG8_WAIT_L(0); PG8_BAR; if constexpr (!HALFU) { PG8_MMA(1, 0, At, B0); PG8_MMA(1, 1, At, B1); } PG8_BAR; PG8_SCHED;
            } else {
            PG8_LDB(B0, 0, 0); PG8_SCHED; PG8_LDA(At, 0, 0); PG8_STAGE(PG8_SA(1, 1), a1 + hstep, voffA);
            PG8_WAIT_L(8); PG8_BAR; PG8_WAIT_L(0); PG8_MMA(0, 0, At, B0); PG8_BAR; PG8_SCHED;
            PG8_LDB(B1, 0, 1); PG8_STAGE(PG8_SB(0, 0), b2, voffB);
            PG8_BAR; PG8_WAIT_L(0); PG8_MMA(0, 1, At, B1); PG8_BAR;
            PG8_LDA(At, 0, 1); PG8_STAGE(PG8_SA(0, 0), a2, voffA);
            PG8_BAR; PG8_WAIT_L(0); PG8_MMA(1, 0, At, B0); PG8_BAR; PG8_SCHED;
            PG8_STAGE(PG8_SB(0, 1), b2 + hstep, voffB);
            PG8_WAIT_V(6); PG8_BAR; PG8_MMA(1, 1, At, B1); PG8_BAR;
            PG8_LDB(B0, 1, 0); PG8_SCHED; PG8_LDA(At, 1, 0); PG8_STAGE(PG8_SA(0, 1), a2 + hstep, voffA);
            PG8_WAIT_L(8); PG8_BAR; PG8_WAIT_L(0); PG8_MMA(0, 0, At, B0); PG8_BAR; PG8_SCHED;
            PG8_LDB(B1, 1, 1); PG8_STAGE(PG8_SB(1, 0), b3, voffB);
            PG8_BAR; PG8_WAIT_L(0); PG8_MMA(0, 1, At, B1); PG8_BAR;
            PG8_LDA(At, 1, 1); PG8_STAGE(PG8_SA(1, 0), a3, voffA);
            PG8_BAR; PG8_WAIT_L(0); PG8_MMA(1, 0, At, B0); PG8_BAR; PG8_SCHED;
            PG8_STAGE(PG8_SB(1, 1), b3 + hstep, voffB);
            PG8_WAIT_V(6); PG8_BAR; PG8_MMA(1, 1, At, B1); PG8_BAR;
            }
        }
        if constexpr (ALIGN_EPI) { if (wr == 0) PG8_BAR; }
        if constexpr (!Epi::AFTER_DRAIN) { E(acc, cur, wr, wc, fr, fq); S.done(cur); }
        if (!has_next) break;
#pragma unroll
        for (int a = 0; a < 2; ++a)
#pragma unroll
            for (int b = 0; b < 2; ++b)
#pragma unroll
                for (int m = 0; m < 4; ++m)
#pragma unroll
                    for (int n = 0; n < 2; ++n) acc[a][b][m][n] = (f32x4){0.f, 0.f, 0.f, 0.f};
        cur = nxt; cA = nA; cB = nB; ++ui;
        if constexpr (ALIGN_EPI) { if (wr == 1) PG8_BAR; }
    }
    PG8_WAIT_V(0);
    if constexpr (!ALIGN_EPI) { if (wr == 0) PG8_BAR; }
    PG8_BAR;
    if constexpr (Epi::AFTER_DRAIN) { E.fused(acc, cur, wr, wc, fr, fq, lds, wid, lane); S.done(cur); }
#undef PG8_SA
#undef PG8_SB
#undef PG8_STAGE
#undef PG8_LDA
#undef PG8_LDB
#undef PG8_MMA
#undef PG8_WAIT_V
#undef PG8_WAIT_L
#undef PG8_BAR
#undef PG8_SCHED
}
}
#define LAS __attribute__((address_space(3)))
typedef unsigned short bf16_t;
typedef float f32x4 __attribute__((ext_vector_type(4)));
typedef float f32x2 __attribute__((ext_vector_type(2)));
typedef float f32x16 __attribute__((ext_vector_type(16)));
typedef short bf16x8 __attribute__((ext_vector_type(8)));
typedef unsigned u32x4 __attribute__((ext_vector_type(4)));
typedef unsigned u32x2 __attribute__((ext_vector_type(2)));
typedef LAS unsigned char* ldsp_t;

constexpr int D = 1024, MROWS = 16384, MP = 8192, DFF = 2816;
constexpr float EPS = 1e-6f;
constexpr float C2 = 0.125f * 1.4426950408889634f;
constexpr float LOG2E = 1.4426950408889634f;

constexpr size_t OUT_X = 0, OUT_AK = 16777216, OUT_AV = 25165824, OUT_BK = 33554432, OUT_BV = 35651584, OUT_CK = 37748736, OUT_CV = 39845888, OUT_SD = 41943040;

constexpr size_t MiB = 1u << 20;
constexpr size_t WS_MODP = 150 * MiB + 192 * MiB;
constexpr size_t WS_TAB = 5 * MiB;
constexpr size_t WS_BIAS = WS_TAB + 512 * 1024;
constexpr size_t WS_ROPE = WS_BIAS + 1 * MiB;
constexpr size_t WS_SMALL = WS_ROPE + 16 * 1024;
constexpr size_t WS_RSS = 7 * MiB;
constexpr size_t WS_W = 10 * MiB;
constexpr size_t W_FF1 = WS_W;
constexpr size_t W_FF2 = W_FF1 + 44 * MiB;
constexpr size_t W_QKVA = W_FF2 + 22 * MiB;
constexpr size_t W_O = W_QKVA + 6 * MiB;
constexpr size_t W_QKVB = W_O + 8 * MiB;
constexpr size_t W_QKVC = W_QKVB + 3 * MiB;
constexpr size_t W_IND = W_QKVC + 3 * MiB;
constexpr size_t WS_CTX = 106 * MiB;
constexpr size_t CTX_KA = WS_CTX, CTX_VA = WS_CTX + 4 * MiB, CTX_KB = WS_CTX + 8 * MiB, CTX_VB = WS_CTX + 9 * MiB, CTX_KC = WS_CTX + 10 * MiB, CTX_VC = WS_CTX + 11 * MiB;
constexpr size_t WS_XS = 118 * MiB;
constexpr size_t WS_BIG = 150 * MiB;
constexpr size_t WS_XB = 342 * MiB;
constexpr size_t WS_END = 374 * MiB;
constexpr size_t B_Q = WS_BIG, B_K = WS_BIG + 32 * MiB, B_V = WS_BIG + 64 * MiB, B_O = WS_BIG + 96 * MiB;
constexpr size_t B_H = WS_BIG;
constexpr size_t B_DQ = WS_BIG, B_DV = WS_BIG + 32 * MiB, B_DG = WS_BIG + 64 * MiB, B_DLF = WS_BIG + 96 * MiB  , B_DOB = WS_BIG + 160 * MiB;

constexpr int SV_QNA = 0, SV_KNA = 64, SV_SUBLN = 128, SV_QNB = 256, SV_KNB = 320, SV_SINK = 384, SV_QNC = 448, SV_KNC = 512, SV_GND = 576, SV_LAM = 704, SV_OSC = 705, SV_LB = 1024;
constexpr int LDS_BYTES = 147456;
constexpr int NTHREADS = 512;

struct Params {
    const float* in[40];
    float* out;
    unsigned char* ws;
    int ph_lo, ph_hi;
};

typedef __bf16 bf16x2_t __attribute__((ext_vector_type(2)));
__device__ __forceinline__ unsigned cvt_pk(float lo, float hi) { const f32x2 v = {lo, hi}; const bf16x2_t b = __builtin_convertvector(v, bf16x2_t); return __builtin_bit_cast(unsigned, b); }
__device__ __forceinline__ unsigned short f2bf(float f) { return (unsigned short)(cvt_pk(f, 0.f) & 0xffffu); }
__device__ __forceinline__ float bf2f(unsigned short b) { return __builtin_bit_cast(float, (unsigned)b << 16); }
__device__ __forceinline__ float fast_exp(float x) { return __builtin_amdgcn_exp2f(x * LOG2E); }
__device__ __forceinline__ float silu_f(float x) { return x * __builtin_amdgcn_rcpf(1.f + fast_exp(-x)); }
__device__ __forceinline__ float sigmoid_f(float x) { return __builtin_amdgcn_rcpf(1.f + fast_exp(-x)); }
__device__ __forceinline__ float max3f(float a, float b, float c) { float r; asm("v_max3_f32 %0, %1, %2, %3" : "=v"(r) : "v"(a), "v"(b), "v"(c)); return r; }
__device__ __forceinline__ int crow(int r, int hi) { return (r & 3) + 8 * (r >> 2) + 4 * hi; }
__device__ __forceinline__ int grp_of_pm(int pm) { return pm < 32 ? 0 : 1 + ((pm - 32) >> 3); }
__device__ __forceinline__ float rstd_of(const float* rss, int row) { const f32x4 s = *(const f32x4*)(rss + (size_t)row * 4); return rsqrtf(((s.x + s.y) + (s.z + s.w)) * (1.f / 1024.f) + EPS); }
__device__ __forceinline__ float lane_xor16(float v) { const auto r = __builtin_amdgcn_permlane16_swap(__float_as_uint(v), __float_as_uint(v), false, false); const int l = __builtin_amdgcn_mbcnt_hi(~0u, __builtin_amdgcn_mbcnt_lo(~0u, 0u)); return __uint_as_float((l & 16) ? r[0] : r[1]); }
__device__ __forceinline__ float lane_xor32(float v) { const auto r = __builtin_amdgcn_permlane32_swap(__float_as_uint(v), __float_as_uint(v), false, false); const int l = __builtin_amdgcn_mbcnt_hi(~0u, __builtin_amdgcn_mbcnt_lo(~0u, 0u)); return __uint_as_float((l & 32) ? r[0] : r[1]); }
__device__ __forceinline__ float wave_sum(float v) {
    v += __uint_as_float((unsigned)__builtin_amdgcn_mov_dpp((int)__float_as_uint(v), 0xB1, 0xF, 0xF, true));
    v += __uint_as_float((unsigned)__builtin_amdgcn_mov_dpp((int)__float_as_uint(v), 0x4E, 0xF, 0xF, true));
    v += __uint_as_float((unsigned)__builtin_amdgcn_mov_dpp((int)__float_as_uint(v), 0x141, 0xF, 0xF, true));
    v += __uint_as_float((unsigned)__builtin_amdgcn_mov_dpp((int)__float_as_uint(v), 0x140, 0xF, 0xF, true));
    v += lane_xor16(v);
    v += lane_xor32(v);
    return v;
}
#define WG_BARRIER() __syncthreads()
__device__ __forceinline__ int fresh_tid(int wid_s) { unsigned m = ~0u; asm volatile("" : "+s"(m)); const int l = (int)__builtin_amdgcn_mbcnt_hi(m, __builtin_amdgcn_mbcnt_lo(m, 0u)); return wid_s * 64 + l; }
#define FRESH_TID(w) fresh_tid(w)
#define LAUNDER_S(p) asm volatile("" : "+s"(p))
#define OPAQUE_PTR(T, name, src) size_t name##_z = 0; LAUNDER_S(name##_z); T name = (src) + name##_z

using pg8::Unit;

__device__ __forceinline__ unsigned dpp_xor1(unsigned v) { return (unsigned)__builtin_amdgcn_mov_dpp((int)v, 0xB1, 0xF, 0xF, true); }
__device__ __forceinline__ unsigned dpp_xor2(unsigned v) { return (unsigned)__builtin_amdgcn_mov_dpp((int)v, 0x4E, 0xF, 0xF, true); }
template <int LAYER> struct EpiQKV {
    static constexpr bool PERM = true, AFTER_DRAIN = false;
    unsigned char* ws_; float* out_; int li;
    __device__ __forceinline__ void operator()(const f32x4 (&acc)[2][2][4][2], const Unit& u, int wr, int wc, int fr_, int fq_) const {
        int fr = fr_, fq = fq_; asm volatile("" : "+v"(fr), "+v"(fq));
        constexpr int NKT = (LAYER == 0) ? 4 : 1, KH = (LAYER == 0) ? 16 : 4, VH = (LAYER == 0) ? 8 : 4, DV = (LAYER == 0) ? 128 : 64;
        const int pn = u.pn, kind = pn < 4 ? 0 : (pn < 4 + NKT ? 1 : 2);
        const int g = grp_of_pm(u.pm); const bool sample = u.pm >= 32;
        OPAQUE_PTR(unsigned char*, ws, ws_); OPAQUE_PTR(float*, outp, out_);
        const float* rss = (const float*)(ws + WS_RSS) + (size_t)(2 * li) * MROWS * 4;
        const float* bias = (const float*)(ws + WS_BIAS) + (size_t)(2 * li) * 5 * 5632; constexpr int nstride = 5632;
        const float* sv = (const float*)(ws + WS_SMALL);
        const float* qg = sv + (li == 0 ? SV_QNA : (li == 1 ? SV_QNB : SV_QNC)); const float* kg = qg + 64;
        bf16_t* Q = (bf16_t*)(ws + B_Q); bf16_t* Kp = (bf16_t*)(ws + B_K); bf16_t* Ks = (bf16_t*)(ws + B_K + 16 * MiB); bf16_t* Vtp = (bf16_t*)(ws + B_V); bf16_t* Vts = (bf16_t*)(ws + B_V + 16 * MiB);
        float* outK = outp + (li == 0 ? OUT_AK : (li == 1 ? OUT_BK : OUT_CK)); float* outV = outp + (li == 0 ? OUT_AV : (li == 1 ? OUT_BV : OUT_CV));
        float rsv[2][4];
#pragma unroll
        for (int ai = 0; ai < 2; ++ai)
#pragma unroll
            for (int m = 0; m < 4; ++m) rsv[ai][m] = rstd_of(rss, u.pm * 256 + (u.half > 0 ? 128 : 0) + ai * 128 + wr * 64 + m * 16 + fr);
        float ifr[2][4];
#pragma unroll
        for (int n = 0; n < 2; ++n)
#pragma unroll
            for (int e = 0; e < 4; ++e) ifr[n][e] = __builtin_amdgcn_exp2f(-(float)(8 * (fq & 1) + 4 * n + e) * (13.287712379549449f / 16.f)) * 0.15915494309189535f;
        const float sgn = (fq & 2) ? 1.f : -1.f;
        f32x4 bv[2][2], gv[2][2];
#pragma unroll
        for (int bj = 0; bj < 2; ++bj)
#pragma unroll
            for (int n = 0; n < 2; ++n) {
                bv[bj][n] = *(const f32x4*)(bias + (size_t)g * nstride + pn * 256 + bj * 128 + wc * 32 + 8 * fq + 4 * n);
                gv[bj][n] = (kind < 2) ? *(const f32x4*)((kind == 0 ? qg : kg) + 32 * bj + 8 * fq + 4 * n) : (f32x4){1.f, 1.f, 1.f, 1.f};
            }
#pragma unroll
        for (int ai = 0; ai < 2; ++ai)
#pragma unroll
            for (int m = 0; m < 4; ++m) {
                if (ai == 1 && u.half >= 0) continue;
                const int row = u.pm * 256 + (u.half > 0 ? 128 : 0) + ai * 128 + wr * 64 + m * 16 + fr;
                const float rs = rsv[ai][m];
                const int b = sample ? ((row - MP) >> 11) : (row >> 8), t = sample ? ((row - MP) & 2047) : (row & 255);
                const int T = sample ? 2048 : 256;
                f32x4 v[2][2];
#pragma unroll
                for (int bj = 0; bj < 2; ++bj)
#pragma unroll
                    for (int n = 0; n < 2; ++n) v[bj][n] = acc[ai][bj][m][n] * rs + bv[bj][n];
                if (kind < 2) {
                    float ss = 0.f;
#pragma unroll
                    for (int bj = 0; bj < 2; ++bj)
#pragma unroll
                        for (int n = 0; n < 2; ++n) { const f32x4 x = v[bj][n]; ss += (x.x * x.x + x.y * x.y) + (x.z * x.z + x.w * x.w); }
                    ss += lane_xor16(ss); ss += lane_xor32(ss);
                    const float r = rsqrtf(ss * (1.f / 64.f) + EPS);
#pragma unroll
                    for (int bj = 0; bj < 2; ++bj)
#pragma unroll
                        for (int n = 0; n < 2; ++n) v[bj][n] = v[bj][n] * r * gv[bj][n];
                    if (sample) {
#pragma unroll
                        for (int bj = 0; bj < 2; ++bj) {
                            const float idx = (float)(bj ? (t & 63) : (t >> 6));
#pragma unroll
                            for (int n = 0; n < 2; ++n)
#pragma unroll
                                for (int e = 0; e < 4; ++e) {
                                    const float mine = v[bj][n][e];
                                    const auto sw = __builtin_amdgcn_permlane32_swap(__float_as_uint(mine), __float_as_uint(mine), false, false);
                                    const float other = __uint_as_float(fq & 2 ? sw[0] : sw[1]);
                                    const float rev = idx * ifr[n][e];
                                    v[bj][n][e] = mine * __builtin_amdgcn_cosf(rev) + sgn * other * __builtin_amdgcn_sinf(rev);
                                }
                        }
                    }
                    if (kind == 0) {
                        bf16_t* dst = Q + (size_t)row * 1024 + (pn * 4 + wc) * 64 + 8 * fq;
#pragma unroll
                        for (int bj = 0; bj < 2; ++bj) { const f32x4 x = v[bj][0] * C2, y = v[bj][1] * C2; u32x4 w; w.x = cvt_pk(x.x, x.y); w.y = cvt_pk(x.z, x.w); w.z = cvt_pk(y.x, y.y); w.w = cvt_pk(y.z, y.w); *(u32x4*)(dst + 32 * bj) = w; }
                    } else {
                        const int kh = (pn - 4) * 4 + wc;
                        bf16_t* dst = (sample ? Ks : Kp) + ((size_t)(b * KH + kh) * T + t) * 64 + 8 * fq;
#pragma unroll
                        for (int bj = 0; bj < 2; ++bj) { const f32x4 x = v[bj][0], y = v[bj][1]; u32x4 w; w.x = cvt_pk(x.x, x.y); w.y = cvt_pk(x.z, x.w); w.z = cvt_pk(y.x, y.y); w.w = cvt_pk(y.z, y.w); *(u32x4*)(dst + 32 * bj) = w;
                            if (!sample) { float* o = outK + (size_t)row * (KH * 64) + kh * 64 + 32 * bj + 8 * fq; *(f32x4*)o = x; *(f32x4*)(o + 4) = y; } }
                    }
                } else {
#pragma unroll
                    for (int bj = 0; bj < 2; ++bj) {
                        const int lcol = (pn - 4 - NKT) * 256 + 64 * wc + 32 * bj + 8 * fq;
                        const int vh = lcol / DV, d0 = lcol % DV;
                        const f32x4 x = v[bj][0], y = v[bj][1];
                        if (!sample) { float* o = outV + (size_t)row * (VH * DV) + lcol; *(f32x4*)o = x; *(f32x4*)(o + 4) = y; }
                        unsigned p0 = cvt_pk(x.x, x.y), p1 = cvt_pk(x.z, x.w), p2 = cvt_pk(y.x, y.y), p3 = cvt_pk(y.z, y.w);
                        const bool odd = fr & 1, hi2 = fr & 2;
                        const unsigned r0 = dpp_xor1(odd ? p0 : p1), r1 = dpp_xor1(odd ? p2 : p3);
                        const unsigned a0 = odd ? r0 : p0, a1 = odd ? p1 : r0, a2 = odd ? r1 : p2, a3 = odd ? p3 : r1;
                        const unsigned q0 = dpp_xor2(hi2 ? a0 : a2), q1 = dpp_xor2(hi2 ? a1 : a3);
                        const unsigned f0 = hi2 ? q0 : a0, f1 = hi2 ? q1 : a1, f2 = hi2 ? a2 : q0, f3 = hi2 ? a3 : q1;
                        u32x2 wlo, whi;
                        wlo.x = (f0 & 0xffffu) | (f1 << 16); wlo.y = (f2 & 0xffffu) | (f3 << 16); whi.x = (f0 >> 16) | (f1 & 0xffff0000u); whi.y = (f2 >> 16) | (f3 & 0xffff0000u);
                        bf16_t* dst = (sample ? Vts : Vtp) + ((size_t)(b * VH + vh) * DV + d0 + 2 * (fr & 3)) * T + (t & ~3);
                        *(u32x2*)dst = wlo; *(u32x2*)(dst + T) = whi;
                    }
                }
            }
    }
};

struct EpiInD {
    static constexpr bool PERM = true, AFTER_DRAIN = false;
    unsigned char* ws_;
    __device__ __forceinline__ void operator()(const f32x4 (&acc)[2][2][4][2], const Unit& u, int wr, int wc, int fr_, int fq_) const {
        int fr = fr_, fq = fq_; asm volatile("" : "+v"(fr), "+v"(fq));
        const int pn = u.pn, kind = pn >> 2;
        const int grp = grp_of_pm(u.pm);
        OPAQUE_PTR(unsigned char*, ws, ws_);
        const float* rss = (const float*)(ws + WS_RSS) + (size_t)6 * MROWS * 4;
        const float* bias = (const float*)(ws + WS_BIAS) + (size_t)6 * 5 * 5632; constexpr int nstride = 5632;
        const float* lbv = (const float*)(ws + WS_SMALL) + SV_LB;
        bf16_t* q = (bf16_t*)(ws + B_DQ); bf16_t* v = (bf16_t*)(ws + B_DV); bf16_t* g = (bf16_t*)(ws + B_DG); _Float16* lf = (_Float16*)(ws + B_DLF);
        float rs[2][4];
#pragma unroll
        for (int ai = 0; ai < 2; ++ai)
#pragma unroll
            for (int m = 0; m < 4; ++m) rs[ai][m] = rstd_of(rss, u.pm * 256 + ai * 128 + wr * 64 + m * 16 + fr);
        f32x4 bva[2][2], lba[2][2];
#pragma unroll
        for (int bj = 0; bj < 2; ++bj)
#pragma unroll
            for (int n = 0; n < 2; ++n) {
                bva[bj][n] = *(const f32x4*)(bias + (size_t)grp * nstride + pn * 256 + bj * 128 + wc * 32 + 8 * fq + 4 * n);
                lba[bj][n] = (kind == 1 || kind == 2) ? *(const f32x4*)(lbv + (kind - 1) * 1024 + (pn & 3) * 256 + 64 * wc + 32 * bj + 8 * fq + 4 * n) : (f32x4){0.f, 0.f, 0.f, 0.f};
            }
#pragma unroll
        for (int bj = 0; bj < 2; ++bj) {
            const int lcol = (pn & 3) * 256 + 64 * wc + 32 * bj + 8 * fq;
#pragma unroll
            for (int ai = 0; ai < 2; ++ai)
#pragma unroll
                for (int m = 0; m < 4; ++m) {
                    const int row = u.pm * 256 + ai * 128 + wr * 64 + m * 16 + fr;
                    f32x4 x = acc[ai][bj][m][0] * rs[ai][m] + bva[bj][0], y = acc[ai][bj][m][1] * rs[ai][m] + bva[bj][1];
                    if (kind == 1 || kind == 2) {
                        typedef _Float16 h8 __attribute__((ext_vector_type(8)));
                        h8 o;
#pragma unroll
                        for (int e = 0; e < 4; ++e) { const float l0 = lba[bj][0][e], l1 = lba[bj][1][e];
                            o[e] = (_Float16)__builtin_amdgcn_logf(l0 + (1.f - l0) * sigmoid_f(x[e]));
                            o[4 + e] = (_Float16)__builtin_amdgcn_logf(l1 + (1.f - l1) * sigmoid_f(y[e])); }
                        *(h8*)(lf + (size_t)row * 2048 + (kind - 1) * 1024 + lcol) = o;
                    } else {
                        if (kind == 0) { x.x = silu_f(x.x); x.y = silu_f(x.y); x.z = silu_f(x.z); x.w = silu_f(x.w); y.x = silu_f(y.x); y.y = silu_f(y.y); y.z = silu_f(y.z); y.w = silu_f(y.w); }
                        bf16_t* dst = (kind == 0 ? q : (kind == 3 ? v : g)) + (size_t)row * 1024 + lcol;
                        u32x4 w; w.x = cvt_pk(x.x, x.y); w.y = cvt_pk(x.z, x.w); w.z = cvt_pk(y.x, y.y); w.w = cvt_pk(y.z, y.w); *(u32x4*)dst = w;
                    }
                }
        }
    }
};

constexpr int EPI_LDS = 131072, EPI_SLOT = 2048, EPI_MAXU = 6;
__device__ __forceinline__ void stage_epi_rb(ldsp_t lds, const pg8::StaticOrder& S, const float* rss, const float* bias, int nstride, int wid_s) {
    const int tid = FRESH_TID(wid_s);
    for (int i = 0; i < EPI_MAXU; ++i) {
        Unit u; if (!S.next(i, u)) break;
        LAS float* sp = (LAS float*)(lds + EPI_LDS + i * EPI_SLOT);
        if (tid < 256) sp[tid] = rstd_of(rss, u.pm * 256 + tid);
        else sp[tid] = bias[(size_t)grp_of_pm(u.pm) * nstride + u.pn * 256 + (tid - 256)];
    }
    WG_BARRIER();
}

struct EpiSwiGLU {
    static constexpr bool PERM = true, AFTER_DRAIN = false;
    unsigned char* ws_; int li; ldsp_t lds_;
    __device__ __forceinline__ void operator()(const f32x4 (&acc)[2][2][4][2], const Unit& u, int wr, int wc, int fr_, int fq_) const {
        int fr = fr_, fq = fq_; asm volatile("" : "+v"(fr), "+v"(fq));
        const int pn = u.pn;
        OPAQUE_PTR(unsigned char*, ws, ws_);
        const LAS float* sp = (const LAS float*)(lds_ + EPI_LDS + u.idx * EPI_SLOT);
        bf16_t* H = (bf16_t*)(ws + B_H);
        float rs[2][4];
#pragma unroll
        for (int ai = 0; ai < 2; ++ai)
#pragma unroll
            for (int m = 0; m < 4; ++m) rs[ai][m] = sp[ai * 128 + wr * 64 + m * 16 + fr];
        f32x4 bga[2], bua[2];
#pragma unroll
        for (int n = 0; n < 2; ++n) { const LAS float* bp = sp + 256 + wc * 32 + 8 * fq + 4 * n; bga[n] = *(const LAS f32x4*)(bp); bua[n] = *(const LAS f32x4*)(bp + 128); }
#pragma unroll
        for (int ai = 0; ai < 2; ++ai)
#pragma unroll
            for (int m = 0; m < 4; ++m) {
                const int row = u.pm * 256 + ai * 128 + wr * 64 + m * 16 + fr;
                u32x4 w;
#pragma unroll
                for (int n = 0; n < 2; ++n) {
                    const f32x4 gt = acc[ai][0][m][n] * rs[ai][m] + bga[n], up = acc[ai][1][m][n] * rs[ai][m] + bua[n];
                    const float h0 = silu_f(gt.x) * up.x, h1 = silu_f(gt.y) * up.y, h2 = silu_f(gt.z) * up.z, h3 = silu_f(gt.w) * up.w;
                    if (n == 0) { w.x = cvt_pk(h0, h1); w.y = cvt_pk(h2, h3); } else { w.z = cvt_pk(h0, h1); w.w = cvt_pk(h2, h3); }
                }
                *(u32x4*)(H + (size_t)row * DFF + pn * 128 + wc * 32 + 8 * fq) = w;
            }
    }
};

struct EpiRes {
    static constexpr bool PERM = true, AFTER_DRAIN = true;
    const float* xin_p; const float* xin_s; unsigned char* ws_; float* out_; int li; int ffn;
    __device__ __forceinline__ void fused(f32x4 (&acc)[2][2][4][2], const Unit& u, int wr, int wc, int fr_, int fq_, PG8_LAS unsigned char* lds, int wid, int lane) const {
        int fr = fr_, fq = fq_; asm volatile("" : "+v"(fr), "+v"(fq));
        const int pn = u.pn, grp = grp_of_pm(u.pm);
        OPAQUE_PTR(unsigned char*, ws, ws_); OPAQUE_PTR(float*, X, out_);
        const float* TAB = (const float*)(ws + WS_TAB);
        const float* gate = TAB + (size_t)li * 5 * 4096 + (ffn ? 3072 : 1024);
        const float* cs = ffn ? (li < 3 ? TAB + (size_t)(li + 1) * 5 * 4096 : (const float*)nullptr) : TAB + (size_t)li * 5 * 4096 + 2048;
        const float* csp = TAB + (size_t)li * 5 * 4096 + (ffn ? 2048 : 0);
        bf16_t* xs = (bf16_t*)(ws + WS_XS);
        float* rss_out = (float*)(ws + WS_RSS) + (size_t)(ffn ? (li < 3 ? 2 * li + 2 : 7) : 2 * li + 1) * MROWS * 4;
        LAS float* P = (LAS float*)lds;
        const bool src_f32 = (li == 0 && !ffn), dst_f32 = (li == 3 && ffn);
        const float* xbase = (u.pm < 32) ? (xin_p + (size_t)(u.pm * 256) * 1024) : (xin_s + (size_t)(u.pm * 256 - MP) * 1024);
        bf16_t* xb = xs + (size_t)(u.pm * 256) * 1024;
        float* xo = X + (size_t)(u.pm * 256) * 1024;
        float ss[2][4];
#pragma unroll
        for (int ai = 0; ai < 2; ++ai)
#pragma unroll
            for (int m = 0; m < 4; ++m) ss[ai][m] = 0.f;
#pragma unroll
        for (int bj = 0; bj < 2; ++bj) {
            const int col = pn * 256 + bj * 128 + wc * 32 + 8 * fq;
            u32x4 rx[2][4];
            if (!src_f32) {
#pragma unroll
                for (int ai = 0; ai < 2; ++ai)
#pragma unroll
                    for (int m = 0; m < 4; ++m) rx[ai][m] = *(const u32x4*)(xb + (size_t)(ai * 128 + wr * 64 + m * 16 + fr) * 1024 + col);
            }
            asm volatile("" ::: "memory");
            const f32x4 g0 = *(const f32x4*)(gate + (size_t)grp * 4096 + col), g1 = *(const f32x4*)(gate + (size_t)grp * 4096 + col + 4);
            f32x4 r0 = {0.f, 0.f, 0.f, 0.f}, r1 = {0.f, 0.f, 0.f, 0.f};
            if (!src_f32) { const f32x4 p0 = *(const f32x4*)(csp + (size_t)grp * 4096 + col), p1 = *(const f32x4*)(csp + (size_t)grp * 4096 + col + 4);
#pragma unroll
                for (int e = 0; e < 4; ++e) { r0[e] = p0[e] != 0.f ? __builtin_amdgcn_rcpf(p0[e]) : 0.f; r1[e] = p1[e] != 0.f ? __builtin_amdgcn_rcpf(p1[e]) : 0.f; } }
            const f32x4 c0 = cs ? *(const f32x4*)(cs + (size_t)grp * 4096 + col) : (f32x4){0.f, 0.f, 0.f, 0.f}, c1 = cs ? *(const f32x4*)(cs + (size_t)grp * 4096 + col + 4) : (f32x4){0.f, 0.f, 0.f, 0.f};
#pragma unroll
            for (int ai = 0; ai < 2; ++ai)
#pragma unroll
                for (int m = 0; m < 4; ++m) {
                    const int rl = ai * 128 + wr * 64 + m * 16 + fr;
                    f32x4 x0, x1;
                    if (src_f32) { x0 = *(const f32x4*)(xbase + (size_t)rl * 1024 + col); x1 = *(const f32x4*)(xbase + (size_t)rl * 1024 + col + 4); }
                    else { const u32x4 w = rx[ai][m];
                        x0 = (f32x4){bf2f(w.x & 0xffff), bf2f(w.x >> 16), bf2f(w.y & 0xffff), bf2f(w.y >> 16)} * r0; x1 = (f32x4){bf2f(w.z & 0xffff), bf2f(w.z >> 16), bf2f(w.w & 0xffff), bf2f(w.w >> 16)} * r1; }
                    const f32x4 n0 = x0 + g0 * acc[ai][bj][m][0], n1 = x1 + g1 * acc[ai][bj][m][1];
                    if (dst_f32) { *(f32x4*)(xo + (size_t)rl * 1024 + col) = n0; *(f32x4*)(xo + (size_t)rl * 1024 + col + 4) = n1; }
                    if (cs) {
                        ss[ai][m] += ((n0.x * n0.x + n0.y * n0.y) + (n0.z * n0.z + n0.w * n0.w)) + ((n1.x * n1.x + n1.y * n1.y) + (n1.z * n1.z + n1.w * n1.w));
                        const f32x4 y0 = n0 * c0, y1 = n1 * c1; u32x4 w; w.x = cvt_pk(y0.x, y0.y); w.y = cvt_pk(y0.z, y0.w); w.z = cvt_pk(y1.x, y1.y); w.w = cvt_pk(y1.z, y1.w);
                        *(u32x4*)(xs + (size_t)(u.pm * 256 + rl) * 1024 + col) = w;
                    }
                }
        }
        if (cs) {
#pragma unroll
            for (int ai = 0; ai < 2; ++ai)
#pragma unroll
                for (int m = 0; m < 4; ++m) { float t = ss[ai][m]; t += lane_xor16(t); t += lane_xor32(t); if (fq == 0) P[(ai * 128 + wr * 64 + m * 16 + fr) * 4 + wc] = t; }
            WG_BARRIER();
            const int tid = wid * 64 + lane;
            if (tid < 256) { const f32x4 p = *(const LAS f32x4*)(P + tid * 4); rss_out[(size_t)(u.pm * 256 + tid) * 4 + pn] = (p.x + p.y) + (p.z + p.w); }
            WG_BARRIER();
        }
    }
};

struct AttnArgs {
    const bf16_t* Q; const bf16_t* Kp; const bf16_t* Ks; const bf16_t* Vtp; const bf16_t* Vts; const bf16_t* cK; const bf16_t* cVt; bf16_t* O;
    const float* sink; int window; float lam; float osc; const float* subln;
};

#define AT_MFMA(a, b, c) __builtin_amdgcn_mfma_f32_32x32x16_bf16(a, b, c, 0, 0, 0)
#define AT_PIN(x) asm volatile("" : "+v"(x))
#define AT_SB() __builtin_amdgcn_sched_barrier(0)
template <int MODE>
__device__ __forceinline__ void attn_unit_rs(ldsp_t lds, const AttnArgs& A, int stream, int b, int hd, int qb, int wid_s) {
    constexpr int DV = MODE == 0 ? 128 : 64, KH = MODE == 0 ? 16 : 4, VH = MODE == 0 ? 8 : 4, NS = MODE == 0 ? 2 : 1, NDB = DV / 32, NPV = 4 * NDB, VPRE = MODE == 0 ? 4 : 8;
    constexpr int NSLOT = MODE == 1 ? 6 : 3, AHEAD = MODE == 1 ? 2 : 1;
    constexpr bool NIC = MODE == 1;
    constexpr int NVL = DV / 64, KBYTES = 64 * 144, VBYTES = DV * 144, STAGE = NS * KBYTES + VBYTES;
    int wid_o = wid_s; asm volatile("" : "+s"(wid_o));
    const int tid = FRESH_TID(wid_s), lane = tid & 63, wid = wid_o, l31 = lane & 31, hi = lane >> 5;
    const int T = stream ? 2048 : 256, base_row = stream ? MP + b * 2048 : b * 256;
    const int msub = MODE == 0 ? (wid & 1) : 0, rb = MODE == 0 ? (wid >> 1) : (wid >> 2);
    const int qhead = MODE == 0 ? 2 * hd + msub : 4 * hd + (wid & 3);
    const int qrow0 = qb * (MODE == 0 ? 128 : 64) + rb * 32;
    const int nctx = stream ? 8 : 0;
    int tlo = 0, thi = T / 64;
    if (A.window && stream) { tlo = qb - 2 < 0 ? 0 : qb - 2; thi = (qb + 2 > 31 ? 31 : qb + 2) + 1; }
    const int NT = nctx + (thi - tlo);
    const bf16_t* Kown = stream ? A.Ks : A.Kp; const bf16_t* Vown = stream ? A.Vts : A.Vtp;
    u32x4 kreg[NS], vreg[NVL];
    auto load_tile = [&](int j) {
        const bool isctx = j < nctx; const int tt = isctx ? j : tlo + (j - nctx); const int TT = isctx ? 512 : T;
        const bf16_t* kb = isctx ? A.cK : Kown; const bf16_t* vb = isctx ? A.cVt : Vown;
#pragma unroll
        for (int s = 0; s < NS; ++s) { const int kh = MODE == 0 ? 2 * hd + s : hd; kreg[s] = *(const u32x4*)(kb + ((size_t)(b * KH + kh) * TT + 64 * tt) * 64 + tid * 8); }
#pragma unroll
        for (int i = 0; i < NVL; ++i) { const int d = (tid >> 3) + 64 * i; vreg[i] = *(const u32x4*)(vb + ((size_t)(b * VH + hd) * DV + d) * TT + 64 * tt + (tid & 7) * 8); }
    };
    auto store_tile = [&](int boff) {
        ldsp_t base = lds + boff;
#pragma unroll
        for (int s = 0; s < NS; ++s) *(LAS u32x4*)(base + s * KBYTES + (tid >> 3) * 144 + (tid & 7) * 16) = kreg[s];
#pragma unroll
        for (int i = 0; i < NVL; ++i) { ldsp_t p = base + NS * KBYTES + ((tid >> 3) + 64 * i) * 144 + (tid & 6) * 16 + (tid & 1) * 8;
            *(LAS u32x2*)(p) = (u32x2){vreg[i].x, vreg[i].y}; *(LAS u32x2*)(p + 16) = (u32x2){vreg[i].z, vreg[i].w}; }
    };
    auto slot = [&](int t) { return (t % NSLOT) * STAGE; };
    load_tile(0);
    bf16x8 qf[4];
    {
        const bf16_t* qp = A.Q + (size_t)(base_row + qrow0 + l31) * 1024 + qhead * 64 + hi * 8;
#pragma unroll
        for (int ds = 0; ds < 4; ++ds) qf[ds] = *(const bf16x8*)(qp + ds * 16);
    }
    constexpr float THR = 4.f;
    float mrun, lrun; bool first;
    if (A.sink) { mrun = A.sink[qhead] * LOG2E; lrun = hi == 0 ? 1.f : 0.f; first = false; } else { mrun = 0.f; lrun = 0.f; first = true; }
    f32x16 negm;
#pragma unroll
    for (int r = 0; r < 16; ++r) negm[r] = -mrun;
    f32x16 o[NDB];
#pragma unroll
    for (int i = 0; i < NDB; ++i) o[i] = f32x16{};
    ldsp_t kp0 = lds + msub * KBYTES + l31 * 144 + hi * 16;
    ldsp_t vp0 = lds + NS * KBYTES + l31 * 144 + hi * 16;
    auto mask_tile = [&](f32x16& C0, f32x16& C1, int j) {
        if (A.window && stream && j >= nctx) {
            const int tt = tlo + (j - nctx), qpos = qrow0 + l31;
            if (tt == qb - 2) {
                int th = qpos - 128 - 64 * tt - 4 * hi; asm volatile("" : "+v"(th));
#pragma unroll
                for (int r = 0; r < 16; ++r) { const int cr = (r & 3) + 8 * (r >> 2); if (cr < th) C0[r] = -1e30f; if (cr + 32 < th) C1[r] = -1e30f; }
            } else if (tt == qb + 2) {
                int th = qpos + 128 - 64 * tt - 4 * hi; asm volatile("" : "+v"(th));
#pragma unroll
                for (int r = 0; r < 16; ++r) { const int cr = (r & 3) + 8 * (r >> 2); if (cr > th) C0[r] = -1e30f; if (cr + 32 > th) C1[r] = -1e30f; }
            }
        }
    };
    auto row_max = [&](f32x16& C0, f32x16& C1) {
#define AT_MX3(a, b, c) __builtin_fmaxf(__builtin_fmaxf((a), (b)), (c))
        float a = AT_MX3(C0[0], C0[1], C1[0]), bb = AT_MX3(C0[2], C0[3], C1[1]); a = AT_MX3(a, C1[2], C1[3]);
#pragma unroll
        for (int r = 4; r < 16; r += 4) { a = AT_MX3(a, C0[r], C0[r + 1]); bb = AT_MX3(bb, C0[r + 2], C0[r + 3]); a = AT_MX3(a, C1[r], C1[r + 1]); bb = AT_MX3(bb, C1[r + 2], C1[r + 3]); }
#undef AT_MX3
        float mx = __builtin_fmaxf(a, bb);
        const auto rr = __builtin_amdgcn_permlane32_swap(__float_as_uint(mx), __float_as_uint(mx), false, false);
        return __builtin_fmaxf(__uint_as_float(rr[0]), __uint_as_float(rr[1]));
    };
    auto step_end = [&]() { asm volatile("s_waitcnt lgkmcnt(0)\n\ts_barrier" ::: "memory"); };
    f32x16 pA0, pA1, pB0, pB1;
    store_tile(slot(0)); if (NT > 1) load_tile(1);
    if (AHEAD == 2) { if (NT > 1) store_tile(slot(1)); if (NT > 2) load_tile(2); }
    step_end();
    {
        bf16x8 kf[8];
#pragma unroll
        for (int g = 0; g < 8; ++g) kf[g] = *(const LAS bf16x8*)(kp0 + (g & 1) * 4608 + (g >> 1) * 32);
#pragma unroll
        for (int ds = 0; ds < 4; ++ds) { pA0 = AT_MFMA(kf[2 * ds], qf[ds], ds == 0 ? (NIC ? negm : f32x16{}) : pA0); pA1 = AT_MFMA(kf[2 * ds + 1], qf[ds], ds == 0 ? (NIC ? negm : f32x16{}) : pA1); }
        mask_tile(pA0, pA1, 0);
        const float mx = NIC ? row_max(pA0, pA1) : row_max(pA0, pA1) - mrun;
        if (first || __any(mx > THR)) {
            const float dl = first ? mx : fmaxf(mx, 0.f);
            mrun += dl;
            if (NIC) {
#pragma unroll
                for (int r = 0; r < 16; ++r) { pA0[r] -= dl; pA1[r] -= dl; negm[r] = -mrun; }
            }
            lrun *= __builtin_amdgcn_exp2f(-dl);
        }
        { const float nm = NIC ? 0.f : -mrun;
#pragma unroll
        for (int r = 0; r < 16; ++r) { pA0[r] = __builtin_amdgcn_exp2f(NIC ? pA0[r] : pA0[r] + nm); pA1[r] = __builtin_amdgcn_exp2f(NIC ? pA1[r] : pA1[r] + nm); } }
        if (NT > AHEAD) store_tile(slot(AHEAD));
        if (NT > AHEAD + 1) load_tile(AHEAD + 1);
        step_end();
    }
    u32x4 pw[4]; bf16x8 vfr[NPV];
#define AT_VRD(i, vb_) do { const int k_ = (i) / NDB, db_ = (i) % NDB; vfr[i] = *(const LAS bf16x8*)((vb_) + db_ * 4608 + k_ * 32); } while (0)
#define AT_VF(i) vfr[i]
#define AT_PWF(k) __builtin_bit_cast(bf16x8, pw[k])
    auto step = [&](f32x16& C0, f32x16& C1, f32x16& P0, f32x16& P1, int j) __attribute__((always_inline)) {
        if (j + AHEAD < NT) store_tile(slot(j + AHEAD));
        if (j + AHEAD + 1 < NT) load_tile(j + AHEAD + 1);
        bf16x8 kf[8];
        ldsp_t kb_ = kp0 + slot(j); ldsp_t vb_ = vp0 + slot(j - 1);
        kf[0] = *(const LAS bf16x8*)(kb_); kf[1] = *(const LAS bf16x8*)(kb_ + 4608);
        AT_SB();
        float sacc = 0.f;
#define AT_GA(g, CN, P) do { if ((g) + 2 < 8) kf[((g) + 2) & 7] = *(const LAS bf16x8*)(kb_ + (((g) + 2) & 1) * 4608 + (((g) + 2) >> 1) * 32); if ((g) < VPRE) AT_VRD(((g) < VPRE ? (g) : 0), vb_); AT_SB(); \
        CN = AT_MFMA(kf[g], qf[(g) >> 1], (g) < 2 ? (NIC ? negm : f32x16{}) : CN); \
        sacc += P[4 * ((g) & 3)]; sacc += P[4 * ((g) & 3) + 1]; sacc += P[4 * ((g) & 3) + 2]; sacc += P[4 * ((g) & 3) + 3]; \
        pw[(g) >> 1][2 * ((g) & 1)] = cvt_pk(P[4 * ((g) & 3)], P[4 * ((g) & 3) + 1]); pw[(g) >> 1][2 * ((g) & 1) + 1] = cvt_pk(P[4 * ((g) & 3) + 2], P[4 * ((g) & 3) + 3]); \
        AT_PIN(pw[(g) >> 1]); AT_PIN(sacc); AT_SB(); } while (0)
        AT_GA(0, C0, P0); AT_GA(1, C1, P0); AT_GA(2, C0, P0); AT_GA(3, C1, P0); AT_GA(4, C0, P1); AT_GA(5, C1, P1); AT_GA(6, C0, P1); AT_GA(7, C1, P1);
        lrun += sacc;
        mask_tile(C0, C1, j);
        const float mx = NIC ? row_max(C0, C1) : row_max(C0, C1) - mrun;
        bool resc = false; float alpha = 1.f;
        if (__builtin_expect(__any(mx > THR), 0)) {
            const float dl = fmaxf(mx, 0.f);
            mrun += dl;
            if (NIC) {
#pragma unroll
                for (int r = 0; r < 16; ++r) { C0[r] -= dl; C1[r] -= dl; negm[r] = -mrun; }
            }
            alpha = __builtin_amdgcn_exp2f(-dl); lrun *= alpha; resc = true;
        }
        float nm = NIC ? 0.f : -mrun; AT_PIN(nm);
        AT_SB();
        constexpr int EPG = 32 / NPV;
#pragma unroll
        for (int i = 0; i < NPV; ++i) {
            if (i + VPRE < NPV) { AT_VRD((i + VPRE < NPV ? i + VPRE : 0), vb_); AT_SB(); }
            o[i % NDB] = AT_MFMA(AT_VF(i), AT_PWF(i / NDB), o[i % NDB]);
            f32x16& X = (i * EPG) < 16 ? C0 : C1;
#pragma unroll
            for (int e = 0; e < EPG; ++e) X[(i * EPG + e) & 15] = __builtin_amdgcn_exp2f(NIC ? X[(i * EPG + e) & 15] : X[(i * EPG + e) & 15] + nm);
            AT_PIN(X); AT_SB();
        }
        if (resc) {
#pragma unroll
            for (int d = 0; d < NDB; ++d)
#pragma unroll
                for (int r = 0; r < 16; ++r) o[d][r] *= alpha;
        }
        if (AHEAD == 1 || (j & 1) == 0) step_end();
    };
    auto drain = [&](f32x16& P0, f32x16& P1) __attribute__((always_inline)) {
        ldsp_t vb_ = vp0 + slot(NT - 1);
        float sacc = 0.f;
#pragma unroll
        for (int r = 0; r < 16; ++r) sacc += P0[r] + P1[r];
        lrun += sacc;
#pragma unroll
        for (int k = 0; k < 4; ++k) { const f32x16& P = k < 2 ? P0 : P1; const int s8 = 8 * (k & 1);
            pw[k] = (u32x4){cvt_pk(P[s8], P[s8 + 1]), cvt_pk(P[s8 + 2], P[s8 + 3]), cvt_pk(P[s8 + 4], P[s8 + 5]), cvt_pk(P[s8 + 6], P[s8 + 7])}; }
#pragma unroll
        for (int i = 0; i < NPV; ++i) { AT_VRD(i, vb_); o[i % NDB] = AT_MFMA(AT_VF(i), AT_PWF(i / NDB), o[i % NDB]); }
    };
    int j = 1;
    for (; j + 1 < NT; j += 2) { step(pB0, pB1, pA0, pA1, j); step(pA0, pA1, pB0, pB1, j + 1); }
    if (j < NT) { step(pB0, pB1, pA0, pA1, j); drain(pB0, pB1); } else drain(pA0, pA1);
    asm volatile("s_waitcnt lgkmcnt(0)\n\ts_barrier" ::: "memory");
#undef AT_VRD
#undef AT_VF
#undef AT_PWF
#undef AT_GA
    const float ltot = lrun + __shfl_xor(lrun, 32);
    const float inv = 1.f / ltot;
    bf16_t* orow = A.O + (size_t)(base_row + qrow0 + l31) * 1024;
    if (MODE == 1) {
        bf16_t* dst = orow + qhead * 64;
#pragma unroll
        for (int db = 0; db < NDB; ++db)
#pragma unroll
            for (int g4 = 0; g4 < 4; ++g4) { u32x2 w; w.x = cvt_pk(o[db][4 * g4] * inv, o[db][4 * g4 + 1] * inv); w.y = cvt_pk(o[db][4 * g4 + 2] * inv, o[db][4 * g4 + 3] * inv);
                *(u32x2*)(dst + 32 * db + 8 * g4 + 4 * hi) = w; }
    } else {
        LAS float* X = (LAS float*)lds + (size_t)rb * 4096;
        if (msub == 1) {
            const float sc = inv * A.lam;
#pragma unroll
            for (int db = 0; db < NDB; ++db)
#pragma unroll
                for (int r = 0; r < 16; ++r) X[(db * 16 + r) * 64 + lane] = o[db][r] * sc;
        }
        WG_BARRIER();
        if (msub == 0) {
            float ss = 0.f;
#pragma unroll
            for (int db = 0; db < NDB; ++db)
#pragma unroll
                for (int r = 0; r < 16; ++r) { const float v = o[db][r] * inv - X[(db * 16 + r) * 64 + lane]; o[db][r] = v; ss += v * v; }
            ss += lane_xor32(ss);
            const float rn = rsqrtf(ss * (1.f / 128.f) + EPS) * A.osc;
            bf16_t* dst = orow + hd * 128;
#pragma unroll
            for (int db = 0; db < NDB; ++db)
#pragma unroll
                for (int g4 = 0; g4 < 4; ++g4) { const int d0 = 32 * db + 8 * g4 + 4 * hi; const f32x4 sg = *(const f32x4*)(A.subln + d0);
                    u32x2 w; w.x = cvt_pk(o[db][4 * g4] * rn * sg.x, o[db][4 * g4 + 1] * rn * sg.y); w.y = cvt_pk(o[db][4 * g4 + 2] * rn * sg.z, o[db][4 * g4 + 3] * rn * sg.w);
                    *(u32x2*)(dst + d0) = w; }
        }
        WG_BARRIER();
    }
}

constexpr int G_QD = 0, G_KIN = 17408, G_KOT = 34816, G_VT = 52224, G_ATT = 60928, G_ST0 = 70144, G_ST1 = 87552, G_DEC = 104960, G_SEG = 105472  ;
struct GlaArgs { const bf16_t* q; const bf16_t* v; const _Float16* lf; bf16_t* o_f; bf16_t* o_b; const float* s0; float* sout; };

struct GlaRegs { _Float16 rl[16]; bf16_t rq[16]; u32x4 rv; };
__device__ __forceinline__ void gla_fetch(const GlaArgs& A, GlaRegs& R, int uc, int n, int tid) {
    const int sk = tid & 127, seg = tid >> 7, vt_t = tid >> 3, vt_ch = tid & 7;
    const int st_ = uc < 128 ? 1 : 0, v_ = st_ ? uc : uc - 128, b_ = v_ >> 5, h_ = (v_ >> 2) & 7, d_ = (v_ >> 1) & 1, vh_ = v_ & 1;
    const int nc_ = st_ ? 32 : 4, br_ = st_ ? MP + b_ * 2048 : b_ * 256;
    const int cidx = d_ ? nc_ - 1 - n : n; const int row0 = br_ + cidx * 64;
    const _Float16* lp = A.lf + (size_t)row0 * 2048 + d_ * 1024 + h_ * 128 + sk;
    const bf16_t* qp = A.q + (size_t)row0 * 1024 + h_ * 128 + sk;
#pragma unroll
    for (int i = 0; i < 16; ++i) { const int p = 16 * seg + i, t = d_ ? 63 - p : p; R.rl[i] = lp[(size_t)t * 2048]; R.rq[i] = qp[(size_t)t * 1024]; }
    R.rv = *(const u32x4*)(A.v + (size_t)(row0 + vt_t) * 1024 + h_ * 128 + vh_ * 64 + vt_ch * 8);
}
__device__ __forceinline__ void gla_unit(ldsp_t lds, const GlaArgs& A, int ucode, int unext, GlaRegs& R, int wid_s) {
    const int stream = ucode < 128 ? 1 : 0, uv = stream ? ucode : ucode - 128, b = uv >> 5, h = (uv >> 2) & 7, dir = (uv >> 1) & 1, vhalf = uv & 1;
    int wid_o = wid_s; asm volatile("" : "+s"(wid_o));
    const int tid = FRESH_TID(wid_s), lane = tid & 63, wid = wid_o, l31 = lane & 31, hi = lane >> 5;
    const int kb = wid & 3, vb = wid >> 2;
    const int T = stream ? 2048 : 256, NC = T / 64, base_row = stream ? MP + b * 2048 : b * 256;
    const int sk = tid & 127, seg = tid >> 7;
    const int vt_t = tid >> 3, vt_ch = tid & 7;
    f32x16 S = f32x16{};
    if (stream) {
        const float* sp = A.s0 + ((size_t)(b * 2 + dir) * 8 + h) * 16384;
#pragma unroll
        for (int r = 0; r < 16; ++r) S[r] = sp[(32 * kb + crow(r, hi)) * 128 + vhalf * 64 + 32 * vb + l31];
    }
    auto publish = [&](int which) {
        ldsp_t st = lds + (which ? G_ST1 : G_ST0) + (32 * vb + l31) * 272;
#pragma unroll
        for (int g4 = 0; g4 < 4; ++g4) { u32x2 w; w.x = cvt_pk(S[4 * g4], S[4 * g4 + 1]); w.y = cvt_pk(S[4 * g4 + 2], S[4 * g4 + 3]); *(LAS u32x2*)(st + (32 * kb + 8 * g4 + 4 * hi) * 2) = w; }
    };
    publish(0);
    int cur = 0;
    bf16_t* obuf = dir ? A.o_b : A.o_f;
    for (int n = 0; n < NC; ++n) {
        const int cidx = dir ? NC - 1 - n : n; const int row0 = base_row + cidx * 64;
        float c[16], kk[16]; float run = 1.f;
#pragma unroll
        for (int i = 0; i < 16; ++i) { const float f = __builtin_amdgcn_exp2f((float)R.rl[i]); kk[i] = 1.f - f; run *= f; c[i] = run; }
        *(LAS float*)(lds + G_SEG + (seg * 128 + sk) * 4) = run;
        {
            ldsp_t p = lds + G_VT + (vt_ch * 8) * 136 + vt_t * 2;
            *(LAS bf16_t*)(p) = (bf16_t)(R.rv.x & 0xffff); *(LAS bf16_t*)(p + 136) = (bf16_t)(R.rv.x >> 16);
            *(LAS bf16_t*)(p + 2 * 136) = (bf16_t)(R.rv.y & 0xffff); *(LAS bf16_t*)(p + 3 * 136) = (bf16_t)(R.rv.y >> 16);
            *(LAS bf16_t*)(p + 4 * 136) = (bf16_t)(R.rv.z & 0xffff); *(LAS bf16_t*)(p + 5 * 136) = (bf16_t)(R.rv.z >> 16);
            *(LAS bf16_t*)(p + 6 * 136) = (bf16_t)(R.rv.w & 0xffff); *(LAS bf16_t*)(p + 7 * 136) = (bf16_t)(R.rv.w >> 16);
        }
        WG_BARRIER();
        {
            const float s0 = *(const LAS float*)(lds + G_SEG + (0 * 128 + sk) * 4), s1 = *(const LAS float*)(lds + G_SEG + (1 * 128 + sk) * 4);
            const float s2 = *(const LAS float*)(lds + G_SEG + (2 * 128 + sk) * 4), s3 = *(const LAS float*)(lds + G_SEG + (3 * 128 + sk) * 4);
            const float tot = (s0 * s1) * (s2 * s3);
            const float pre = seg == 0 ? 1.f : (seg == 1 ? s0 : (seg == 2 ? s0 * s1 : s0 * s1 * s2));
            if (seg == 0) *(LAS float*)(lds + G_DEC + sk * 4) = tot;
            const f32x2 pre2 = {pre, pre}, tot2 = {tot, tot};
            unsigned ko[8];
#pragma unroll
            for (int i = 0; i < 16; i += 2) {
                const f32x2 e = (f32x2){c[i], c[i + 1]} * pre2;
                const f32x2 r = {__builtin_amdgcn_rcpf(e.x), __builtin_amdgcn_rcpf(e.y)};
                const unsigned qw = (unsigned)R.rq[i] | ((unsigned)R.rq[i + 1] << 16);
                const f32x2 qf = {__builtin_bit_cast(float, qw << 16), __builtin_bit_cast(float, qw & 0xffff0000u)};
                const f32x2 qd = qf * e, ki = (f32x2){kk[i], kk[i + 1]} * r, kt = ki * tot2;
                const unsigned wq = cvt_pk(qd.x, qd.y), wk = cvt_pk(ki.x, ki.y);
                const int p0 = 16 * seg + i, t0 = dir ? 63 - p0 : p0, t1 = dir ? t0 - 1 : t0 + 1;
                *(LAS bf16_t*)(lds + G_QD + t0 * 272 + sk * 2) = (bf16_t)(wq & 0xffff);
                *(LAS bf16_t*)(lds + G_QD + t1 * 272 + sk * 2) = (bf16_t)(wq >> 16);
                *(LAS bf16_t*)(lds + G_KIN + t0 * 272 + sk * 2) = (bf16_t)(wk & 0xffff);
                *(LAS bf16_t*)(lds + G_KIN + t1 * 272 + sk * 2) = (bf16_t)(wk >> 16);
                ko[i >> 1] = dir ? cvt_pk(kt.y, kt.x) : cvt_pk(kt.x, kt.y);
            }
            ldsp_t kp = lds + G_KOT + sk * 136 + (dir ? 48 - 16 * seg : 16 * seg) * 2;
#pragma unroll
            for (int j = 0; j < 4; ++j) { const u32x2 w = dir ? (u32x2){ko[7 - 2 * j - 1], ko[7 - 2 * j]} : (u32x2){ko[2 * j], ko[2 * j + 1]};
                *(LAS u32x2*)(kp + 8 * j) = dir ? (u32x2){ko[7 - 2 * j], ko[7 - 2 * j - 1]} : w; }
        }
        { int fu = n + 1 < NC ? ucode : unext; const int fn = n + 1 < NC ? n + 1 : 0; asm volatile("" : "+s"(fu)); if (fu >= 0) gla_fetch(A, R, fu, fn, tid); }
        WG_BARRIER();
        if (wid < 3) {
            const int cb = dir == 0 ? (wid >= 1 ? 1 : 0) : (wid == 2 ? 1 : 0);
            const int sb = dir == 0 ? (wid == 2 ? 1 : 0) : (wid >= 1 ? 1 : 0);
            f32x16 a = f32x16{};
#pragma unroll
            for (int half = 0; half < 2; ++half) {
                bf16x8 fa[4], fb[4];
#pragma unroll
                for (int k4 = 0; k4 < 4; ++k4) { const int ks = 4 * half + k4;
                    fa[k4] = *(const LAS bf16x8*)(lds + G_QD + (32 * cb + l31) * 272 + ks * 32 + hi * 16);
                    fb[k4] = *(const LAS bf16x8*)(lds + G_KIN + (32 * sb + l31) * 272 + ks * 32 + hi * 16); }
#pragma unroll
                for (int k4 = 0; k4 < 4; ++k4) a = __builtin_amdgcn_mfma_f32_32x32x16_bf16(fa[k4], fb[k4], a, 0, 0, 0);
                __builtin_amdgcn_sched_group_barrier(0x100, 8, 0);
                __builtin_amdgcn_sched_group_barrier(0x008, 4, 0);
            }
            const int s = 32 * sb + l31;
#pragma unroll
            for (int r = 0; r < 16; ++r) { const int cc = 32 * cb + crow(r, hi); const bool keep = dir == 0 ? (cc >= s) : (cc <= s);
                *(LAS bf16_t*)(lds + G_ATT + cc * 144 + s * 2) = f2bf(keep ? a[r] : 0.f); }
        } else if (wid == 3) {
            const int cb = dir == 0 ? 0 : 1, sb = dir == 0 ? 1 : 0;
            ldsp_t p = lds + G_ATT + (32 * cb + l31) * 144 + (32 * sb + 16 * hi) * 2;
            *(LAS u32x4*)(p) = (u32x4){0u, 0u, 0u, 0u}; *(LAS u32x4*)(p + 16) = (u32x4){0u, 0u, 0u, 0u};
        }
        WG_BARRIER();
        if (wid < 4) {
            const int cb = wid & 1, vbo = wid >> 1;
            f32x16 a = f32x16{};
            {
                bf16x8 fa[4]; u32x2 vx[4], vy[4];
#pragma unroll
                for (int ks = 0; ks < 4; ++ks) {
                    fa[ks] = *(const LAS bf16x8*)(lds + G_ATT + (32 * cb + l31) * 144 + ks * 32 + hi * 16);
                    ldsp_t p = lds + G_VT + (32 * vbo + l31) * 136 + ks * 32 + hi * 16;
                    vx[ks] = *(const LAS u32x2*)(p); vy[ks] = *(const LAS u32x2*)(p + 8);
                }
#pragma unroll
                for (int ks = 0; ks < 4; ++ks) a = __builtin_amdgcn_mfma_f32_32x32x16_bf16(fa[ks], __builtin_bit_cast(bf16x8, (u32x4){vx[ks].x, vx[ks].y, vy[ks].x, vy[ks].y}), a, 0, 0, 0);
                __builtin_amdgcn_sched_group_barrier(0x100, 8, 0);
                __builtin_amdgcn_sched_group_barrier(0x008, 4, 0);
            }
            ldsp_t stp = lds + (cur ? G_ST1 : G_ST0);
#pragma unroll
            for (int half = 0; half < 2; ++half) {
                bf16x8 fa[4], fb[4];
#pragma unroll
                for (int k4 = 0; k4 < 4; ++k4) { const int ks = 4 * half + k4;
                    fa[k4] = *(const LAS bf16x8*)(lds + G_QD + (32 * cb + l31) * 272 + ks * 32 + hi * 16);
                    fb[k4] = *(const LAS bf16x8*)(stp + (32 * vbo + l31) * 272 + ks * 32 + hi * 16); }
#pragma unroll
                for (int k4 = 0; k4 < 4; ++k4) a = __builtin_amdgcn_mfma_f32_32x32x16_bf16(fa[k4], fb[k4], a, 0, 0, 0);
                __builtin_amdgcn_sched_group_barrier(0x100, 8, 0);
                __builtin_amdgcn_sched_group_barrier(0x008, 4, 0);
            }
            bf16_t* op = obuf + (size_t)row0 * 1024 + h * 128 + vhalf * 64 + 32 * vbo + l31;
#pragma unroll
            for (int r = 0; r < 16; ++r) op[(size_t)(32 * cb + crow(r, hi)) * 1024] = f2bf(a[r]);
        }
        {
#pragma unroll
            for (int r = 0; r < 16; ++r) S[r] *= *(const LAS float*)(lds + G_DEC + (32 * kb + crow(r, hi)) * 4);
            u32x2 a0[4], a1[4], b0[4], b1[4];
#pragma unroll
            for (int ks = 0; ks < 4; ++ks) {
                ldsp_t pa = lds + G_KOT + (32 * kb + l31) * 136 + ks * 32 + hi * 16;
                ldsp_t pb = lds + G_VT + (32 * vb + l31) * 136 + ks * 32 + hi * 16;
                a0[ks] = *(const LAS u32x2*)(pa); a1[ks] = *(const LAS u32x2*)(pa + 8); b0[ks] = *(const LAS u32x2*)(pb); b1[ks] = *(const LAS u32x2*)(pb + 8);
            }
#pragma unroll
            for (int ks = 0; ks < 4; ++ks)
                S = __builtin_amdgcn_mfma_f32_32x32x16_bf16(__builtin_bit_cast(bf16x8, (u32x4){a0[ks].x, a0[ks].y, a1[ks].x, a1[ks].y}), __builtin_bit_cast(bf16x8, (u32x4){b0[ks].x, b0[ks].y, b1[ks].x, b1[ks].y}), S, 0, 0, 0);
            __builtin_amdgcn_sched_group_barrier(0x100, 8, 0);
            __builtin_amdgcn_sched_group_barrier(0x008, 4, 0);
            publish(cur ^ 1);
        }
        WG_BARRIER();
        cur ^= 1;
    }
    if (!stream) {
        float* sp = A.sout + ((size_t)(b * 2 + dir) * 8 + h) * 16384;
#pragma unroll
        for (int r = 0; r < 16; ++r) sp[(32 * kb + crow(r, hi)) * 128 + vhalf * 64 + 32 * vb + l31] = S[r];
    }
}

__device__ __forceinline__ void transpose_item(const float* W, int ldw, int scol, int k0, bf16_t* WT, int K, int drow, LAS float* scr, int lane) {
    const int kr = lane >> 3, c4 = lane & 7;
    f32x4 r[8];
#pragma unroll
    for (int i = 0; i < 8; ++i) r[i] = *(const f32x4*)(W + (size_t)(k0 + 8 * i + kr) * ldw + scol + 4 * c4);
#pragma unroll
    for (int i = 0; i < 8; ++i) { LAS float* d = scr + (8 * i + kr) * 33 + 4 * c4; d[0] = r[i].x; d[1] = r[i].y; d[2] = r[i].z; d[3] = r[i].w; }
    asm volatile("s_waitcnt lgkmcnt(0)" ::: "memory");
    const int c = lane & 7;
#pragma unroll
    for (int j = 0; j < 4; ++j) { const int n = (lane >> 3) + 8 * j; const LAS float* s = scr + (8 * c) * 33 + n;
        u32x4 o; o.x = cvt_pk(s[0 * 33], s[1 * 33]); o.y = cvt_pk(s[2 * 33], s[3 * 33]); o.z = cvt_pk(s[4 * 33], s[5 * 33]); o.w = cvt_pk(s[6 * 33], s[7 * 33]);
        *(u32x4*)(WT + (size_t)(drow + n) * K + k0 + 8 * c) = o; }
    asm volatile("s_waitcnt lgkmcnt(0)" ::: "memory");
}
__device__ __forceinline__ int qkv_src_col(int c) { const int tile = c >> 8, w = c & 255; return tile * 256 + 64 * ((w >> 5) & 3) + 32 * (w >> 7); }

__device__ __forceinline__ float cond_val(const Params& P, int g, int k) { const float x = g == 0 ? P.in[10][k] : P.in[2][(g - 1) * 1024 + k]; return x / (1.f + expf(-x)); }
__device__ __forceinline__ float mod_val(const Params& P, int li, int g, int ch, int col) {
    return ((const float*)(P.ws + WS_MODP))[((size_t)li * 5 + g) * 6144 + ch * 1024 + col];
}

__device__ __forceinline__ int layer_items(int l) { return (l == 0 ? 16 * 96 : (l == 3 ? 16 * 160 : 16 * 48)) + 16 * 32 + 16 * 176 + 44 * 32; }
__device__ __forceinline__ void convert_layer_item(const Params& P, unsigned char* ws, int l, int j, LAS float* scr, int lane) {
    const int NB = l == 0 ? 96 : (l == 3 ? 160 : 48), IM = 16 * NB;
    int r = j;
    if (r < IM) { const int kbk = r / NB, nb = r % NB; const int wi = l == 0 ? 18 : (l == 1 ? 27 : (l == 2 ? 32 : 36));
        bf16_t* dst = (bf16_t*)(ws + (l == 0 ? W_QKVA : (l == 1 ? W_QKVB : (l == 2 ? W_QKVC : W_IND))));
        transpose_item(P.in[wi], NB * 32, qkv_src_col(nb * 32), kbk * 64, dst, 1024, nb * 32, scr, lane); return; } r -= IM;
    if (r < 512) { const int kbk = r / 32, nb = r % 32; const int wi = l == 0 ? 19 : (l == 1 ? 28 : (l == 2 ? 33 : 37));
        transpose_item(P.in[wi], 1024, nb * 32, kbk * 64, (bf16_t*)(ws + W_O) + (size_t)l * 1048576, 1024, nb * 32, scr, lane); return; } r -= 512;
    if (r < 16 * 176) { const int kbk = r / 176, nb = r % 176; const int c = nb * 32, tile = c >> 8, w = c & 255, bj = w >> 7, jj = w & 127;
        transpose_item(P.in[bj ? 16 : 15] + (size_t)l * 1024 * 2816, 2816, tile * 128 + jj, kbk * 64, (bf16_t*)(ws + W_FF1) + (size_t)l * 5632 * 1024, 1024, nb * 32, scr, lane); return; } r -= 16 * 176;
    { const int kbk = r / 32, nb = r % 32;
        transpose_item(P.in[17] + (size_t)l * 2816 * 1024, 1024, nb * 32, kbk * 64, (bf16_t*)(ws + W_FF2) + (size_t)l * 1024 * 2816, 2816, nb * 32, scr, lane); }
}

__device__ __forceinline__ void phase_p0a(const Params& P, ldsp_t lds, int wid_s) {
    const int tid = FRESH_TID(wid_s), lane = tid & 63, wid = wid_s;
    const int gw = blockIdx.x * 8 + wid, NGW = gridDim.x * 8;
    LAS float* scr = (LAS float*)(lds + wid * 17408);
    unsigned char* ws = P.ws;
    if (blockIdx.x < 96) {
        LAS float* shc = (LAS float*)lds; LAS float* red = (LAS float*)(lds + 20480);
        for (int i = tid; i < 5 * 1024; i += NTHREADS) shc[i] = cond_val(P, i >> 10, i & 1023);
        WG_BARRIER();
        const int li = blockIdx.x / 24, jg = blockIdx.x % 24;
        const float* W = P.in[13] + ((size_t)li * 1024 + wid * 128) * 6144 + jg * 256 + 4 * lane;
        f32x4 a[5];
#pragma unroll
        for (int g = 0; g < 5; ++g) a[g] = (f32x4){0.f, 0.f, 0.f, 0.f};
        for (int kk = 0; kk < 128; kk += 16) {
            f32x4 w[16];
#pragma unroll
            for (int i = 0; i < 16; ++i) w[i] = *(const f32x4*)(W + (size_t)(kk + i) * 6144);
#pragma unroll
            for (int i = 0; i < 16; ++i)
#pragma unroll
                for (int g = 0; g < 5; ++g) a[g] += shc[g * 1024 + wid * 128 + kk + i] * w[i];
        }
#pragma unroll
        for (int g = 0; g < 5; ++g) *(LAS f32x4*)(red + (wid * 5 + g) * 256 + 4 * lane) = a[g];
        WG_BARRIER();
        float* mp = (float*)(ws + WS_MODP);
        for (int o = tid; o < 5 * 256; o += NTHREADS) {
            const int g = o >> 8, c = o & 255; float sum = P.in[14][li * 6144 + jg * 256 + c];
#pragma unroll
            for (int w = 0; w < 8; ++w) sum += red[(w * 5 + g) * 256 + c];
            mp[((size_t)li * 5 + g) * 6144 + jg * 256 + c] = sum;
        }
        WG_BARRIER();
    }
    if (gridDim.x == 256) {
        const int nit0 = layer_items(0);
        for (int base = 0, rnd = 0; base < nit0; ++rnd) {
            const bool all = (rnd & 1) == 0; const int nw = all ? 2048 : 1280; const int my = all ? gw : (blockIdx.x >= 96 ? gw - 768 : -1);
            if (my >= 0 && base + my < nit0) convert_layer_item(P, ws, 0, base + my, scr, lane);
            base += nw;
        }
    } else for (int it = gw; it < layer_items(0); it += NGW) convert_layer_item(P, ws, 0, it, scr, lane);
    if (gridDim.x != 256) for (int l = 1; l < 4; ++l) for (int it = gw; it < layer_items(l); it += NGW) convert_layer_item(P, ws, l, it, scr, lane);
    {
        const bool late = gridDim.x == 256;
        const int gt = late ? ((int)blockIdx.x - 96) * NTHREADS + tid : blockIdx.x * NTHREADS + tid, NGT = late ? 160 * NTHREADS : gridDim.x * NTHREADS;
        if (gt >= 0) for (int which = 0; which < 3; ++which) {
            const int KH = which == 0 ? 16 : 4; const float* src = P.in[which == 0 ? 3 : (which == 1 ? 5 : 7)];
            bf16_t* dst = (bf16_t*)(ws + (which == 0 ? CTX_KA : (which == 1 ? CTX_KB : CTX_KC)));
            const int n8 = 4 * KH * 512 * 8;
            for (int i = gt; i < n8; i += NGT) {
                const int c8 = i & 7, key = (i >> 3) & 511, kh = (i >> 12) % KH, b = (i >> 12) / KH;
                const float* s = src + ((size_t)(b * 512 + key) * KH + kh) * 64 + c8 * 8;
                const f32x4 x = *(const f32x4*)s, y = *(const f32x4*)(s + 4);
                u32x4 o; o.x = cvt_pk(x.x, x.y); o.y = cvt_pk(x.z, x.w); o.z = cvt_pk(y.x, y.y); o.w = cvt_pk(y.z, y.w);
                *(u32x4*)(dst + (size_t)i * 8) = o;
            }
        }
    }
    {
        for (int which = 0; which < 3; ++which) {
            const int VH = which == 0 ? 8 : 4, DV = which == 0 ? 128 : 64, NDB = DV / 64; const float* src = P.in[which == 0 ? 4 : (which == 1 ? 6 : 8)];
            bf16_t* dst = (bf16_t*)(ws + (which == 0 ? CTX_VA : (which == 1 ? CTX_VB : CTX_VC)));
            const int nit = 4 * VH * 8 * NDB; const bool late = gridDim.x == 256; const int gwv = late ? gw - 768 : gw, ngwv = late ? 1280 : NGW;
            if (gwv >= 0) for (int it = gwv; it < nit; it += ngwv) {
                const int dbk = it % NDB, kbk = (it / NDB) & 7, vh = (it / (NDB * 8)) % VH, b = it / (NDB * 8 * VH);
                for (int k8 = 0; k8 < 64; k8 += 16) { float t[16];
#pragma unroll
                    for (int q = 0; q < 16; ++q) t[q] = src[((size_t)(b * 512 + kbk * 64 + k8 + q) * VH + vh) * DV + dbk * 64 + lane];
#pragma unroll
                    for (int q = 0; q < 16; ++q) scr[(k8 + q) * 65 + lane] = t[q]; }
                asm volatile("s_waitcnt lgkmcnt(0)" ::: "memory");
#pragma unroll 16
                for (int dd = 0; dd < 64; ++dd) dst[((size_t)(b * VH + vh) * DV + dbk * 64 + dd) * 512 + kbk * 64 + lane] = f2bf(scr[lane * 65 + dd]);
                asm volatile("s_waitcnt lgkmcnt(0)" ::: "memory");
            }
        }
    }
    if (blockIdx.x == (gridDim.x > 1 ? 1 : 0)) {
        float* sv = (float*)(ws + WS_SMALL);
        if (tid < 64) { sv[SV_QNA + tid] = P.in[20][tid]; sv[SV_KNA + tid] = P.in[21][tid]; sv[SV_QNB + tid] = P.in[29][tid]; sv[SV_KNB + tid] = P.in[30][tid]; sv[SV_QNC + tid] = P.in[34][tid]; sv[SV_KNC + tid] = P.in[35][tid]; }
        if (tid < 128) { sv[SV_SUBLN + tid] = P.in[22][tid]; sv[SV_GND + tid] = P.in[38][tid]; }
        if (tid < 16) sv[SV_SINK + tid] = P.in[31][tid];
        if (wid == 0) { const float d1 = wave_sum(P.in[23][lane] * P.in[24][lane]), d2 = wave_sum(P.in[25][lane] * P.in[26][lane]);
            const float lam_init = 0.8f - 0.6f;
            if (lane == 0) { sv[SV_LAM] = expf(d1) - expf(d2) + lam_init; sv[SV_OSC] = 1.f - lam_init; } }
        for (int i = tid; i < 2048; i += NTHREADS) { const int dir = i >> 10, k = i & 1023; const float* L = P.in[39] + (size_t)dir * 4096 + k;
            const float l0 = L[0], l1 = L[1024], l2 = L[2048], l3 = L[3072]; const float mx = fmaxf(fmaxf(l0, l1), fmaxf(l2, l3));
            const float e0 = expf(l0 - mx), e1 = expf(l1 - mx), e2 = expf(l2 - mx), e3 = expf(l3 - mx);
            sv[SV_LB + i] = (e1 + e2 + e3) / (e0 + e1 + e2 + e3); }
    }
    if (blockIdx.x == 0) {
        float* rc = (float*)(ws + WS_ROPE); float* rsn = rc + 1024;
        for (int i = tid; i < 1024; i += NTHREADS) { const int idx = i >> 4, fi = i & 15; const float inv = powf(10000.f, -(float)fi / 16.f); const float ang = (float)idx * inv; rc[i] = cosf(ang); rsn[i] = sinf(ang); }
    }
}

__device__ __forceinline__ void phase_p0b(const Params& P, ldsp_t lds, int wid_s) {
    const int tid = FRESH_TID(wid_s), lane = tid & 63, wid = wid_s;
    unsigned char* ws = P.ws;
    LAS float* sh = (LAS float*)lds;
    {
        float* T = (float*)(ws + WS_TAB);
        const int gt = blockIdx.x * NTHREADS + tid, NGT = gridDim.x * NTHREADS;
        for (int i = gt; i < 4 * 5 * 4 * 1024; i += NGT) {
            const int col = i & 1023, j = (i >> 10) & 3, g = (i >> 12) % 5, li = (i >> 12) / 5;
            float v;
            if (j == 0) v = P.in[11][li * 1024 + col] * (1.f + mod_val(P, li, g, 1, col));
            else if (j == 1) v = mod_val(P, li, g, 2, col);
            else if (j == 2) v = P.in[12][li * 1024 + col] * (1.f + mod_val(P, li, g, 4, col));
            else v = mod_val(P, li, g, 5, col);
            T[i] = v;
        }
    }
    {
        float* BIAS = (float*)(ws + WS_BIAS);
        LAS float* red = (LAS float*)(lds + 20480);
        for (int u = blockIdx.x; u < 132; u += gridDim.x) {
            int seg, tile;
            if (u < 12) { seg = 0; tile = u; } else if (u < 18) { seg = 2; tile = u - 12; } else if (u < 24) { seg = 4; tile = u - 18; } else if (u < 44) { seg = 6; tile = u - 24; }
            else { const int q = u - 44; seg = 2 * (q / 22) + 1; tile = q % 22; }
            const int li = seg >> 1, ffn = seg & 1;
            WG_BARRIER();
            for (int i = tid; i < 5 * 1024; i += NTHREADS) sh[i] = mod_val(P, li, i >> 10, ffn ? 3 : 0, i & 1023);
            WG_BARRIER();
            const int c = 4 * lane, bj = c >> 7;
            const float* W; int ldw;
            if (ffn) { W = P.in[bj ? 16 : 15] + (size_t)li * 1024 * 2816 + tile * 128 + (c & 127); ldw = 2816; }
            else { ldw = li == 0 ? 3072 : (li == 3 ? 5120 : 1536); W = P.in[li == 0 ? 18 : (li == 1 ? 27 : (li == 2 ? 32 : 36))] + tile * 256 + 64 * ((c >> 5) & 3) + 32 * bj + (c & 31); }
            W += (size_t)(wid * 128) * ldw;
            f32x4 a[5];
#pragma unroll
            for (int g = 0; g < 5; ++g) a[g] = (f32x4){0.f, 0.f, 0.f, 0.f};
            for (int kk = 0; kk < 128; kk += 8) {
                f32x4 w[8];
#pragma unroll
                for (int i = 0; i < 8; ++i) w[i] = *(const f32x4*)(W + (size_t)(kk + i) * ldw);
#pragma unroll
                for (int i = 0; i < 8; ++i)
#pragma unroll
                    for (int g = 0; g < 5; ++g) a[g] += sh[g * 1024 + wid * 128 + kk + i] * w[i];
            }
#pragma unroll
            for (int g = 0; g < 5; ++g) *(LAS f32x4*)(red + (wid * 5 + g) * 256 + 4 * lane) = a[g];
            WG_BARRIER();
            for (int o = tid; o < 5 * 256; o += NTHREADS) {
                const int g = o >> 8, cc = o & 255; float sum = 0.f;
#pragma unroll
                for (int w = 0; w < 8; ++w) sum += red[(w * 5 + g) * 256 + cc];
                BIAS[((size_t)seg * 5 + g) * 5632 + tile * 256 + cc] = sum;
            }
        }
        WG_BARRIER();
    }
    {
        for (int i = tid; i < 5 * 1024; i += NTHREADS) sh[i] = P.in[11][i & 1023] * (1.f + mod_val(P, 0, i >> 10, 1, i & 1023));
        WG_BARRIER();
        bf16_t* XS = (bf16_t*)(ws + WS_XS); float* RSS = (float*)(ws + WS_RSS);
        const int gw = blockIdx.x * 8 + wid, NGW = gridDim.x * 8;
        for (int row = gw; row < MROWS; row += NGW) {
            const float* xr = row < MP ? P.in[0] + (size_t)row * 1024 : P.in[1] + (size_t)(row - MP) * 1024;
            const int g = row < MP ? 0 : 1 + ((row - MP) >> 11);
            float ss = 0.f;
#pragma unroll
            for (int j = 0; j < 4; ++j) { const f32x4 x = *(const f32x4*)(xr + 256 * j + 4 * lane); ss += (x.x * x.x + x.y * x.y) + (x.z * x.z + x.w * x.w);
                const f32x4 c = *(const LAS f32x4*)(sh + g * 1024 + 256 * j + 4 * lane); const f32x4 y = x * c;
                u32x2 w; w.x = cvt_pk(y.x, y.y); w.y = cvt_pk(y.z, y.w); *(u32x2*)(XS + (size_t)row * 1024 + 256 * j + 4 * lane) = w; }
            ss = wave_sum(ss);
            if (lane == 0) *(f32x4*)(RSS + (size_t)row * 4) = (f32x4){ss, 0.f, 0.f, 0.f};
        }
        WG_BARRIER();
    }
}

__device__ __forceinline__ void phase_gnorm(const Params& P, int wid_s) {
    const int tid = FRESH_TID(wid_s), lane = tid & 63, wid = wid_s;
    const int gw = blockIdx.x * 8 + wid, NGW = gridDim.x * 8;
    const bf16_t* of = (const bf16_t*)(P.ws + WS_XB); const bf16_t* ob = (const bf16_t*)(P.ws + B_DOB); bf16_t* gb = (bf16_t*)(P.ws + B_DG);
    const float* gn = (const float*)(P.ws + WS_SMALL) + SV_GND;
    float gnv[16];
#pragma unroll
    for (int i = 0; i < 16; ++i) gnv[i] = gn[(lane & 7) * 16 + i];
    for (int row = gw; row < MROWS; row += NGW) {
        const size_t off = (size_t)row * 1024 + lane * 16;
        const u32x4 a0 = *(const u32x4*)(of + off), a1 = *(const u32x4*)(of + off + 8), b0 = *(const u32x4*)(ob + off), b1 = *(const u32x4*)(ob + off + 8), g0 = *(const u32x4*)(gb + off), g1 = *(const u32x4*)(gb + off + 8);
        float o[16], gg[16];
#pragma unroll
        for (int i = 0; i < 4; ++i) {
            o[2 * i] = bf2f(a0[i] & 0xffff) + bf2f(b0[i] & 0xffff); o[2 * i + 1] = bf2f(a0[i] >> 16) + bf2f(b0[i] >> 16);
            o[8 + 2 * i] = bf2f(a1[i] & 0xffff) + bf2f(b1[i] & 0xffff); o[8 + 2 * i + 1] = bf2f(a1[i] >> 16) + bf2f(b1[i] >> 16);
            gg[2 * i] = bf2f(g0[i] & 0xffff); gg[2 * i + 1] = bf2f(g0[i] >> 16); gg[8 + 2 * i] = bf2f(g1[i] & 0xffff); gg[8 + 2 * i + 1] = bf2f(g1[i] >> 16);
        }
        float ss = 0.f;
#pragma unroll
        for (int i = 0; i < 16; ++i) ss += o[i] * o[i];
        ss += __shfl_xor(ss, 1); ss += __shfl_xor(ss, 2); ss += __shfl_xor(ss, 4);
        const float r = rsqrtf(ss * (1.f / 128.f) + EPS);
        u32x4 w0, w1;
#pragma unroll
        for (int i = 0; i < 4; ++i) {
            w0[i] = cvt_pk(o[2 * i] * r * gnv[2 * i] * silu_f(gg[2 * i]), o[2 * i + 1] * r * gnv[2 * i + 1] * silu_f(gg[2 * i + 1]));
            w1[i] = cvt_pk(o[8 + 2 * i] * r * gnv[8 + 2 * i] * silu_f(gg[8 + 2 * i]), o[8 + 2 * i + 1] * r * gnv[8 + 2 * i + 1] * silu_f(gg[8 + 2 * i + 1]));
        }
        *(u32x4*)(gb + off) = w0; *(u32x4*)(gb + off + 8) = w1;
    }
}

typedef __attribute__((address_space(1))) unsigned gu32;
#define XB_TMO      128
#define XB_XCNT(j)  (256  + 64 * (j))
#define XB_XSUB(j)  (1280 + 64 * (j))
#define XB_XGEN(j)  (2304 + 64 * (j))
#define XB_TOP      3328
#define XB_TOPGEN   3392
#define XCD_BAR_WORDS 3456
#define XB_SPIN_CAP (1u << 18)

__device__ __forceinline__ unsigned xb_ld(unsigned* p)              { return __hip_atomic_load(p, __ATOMIC_RELAXED, __HIP_MEMORY_SCOPE_AGENT); }
__device__ __forceinline__ unsigned xb_add(unsigned* p, unsigned v) { return __hip_atomic_fetch_add(p, v, __ATOMIC_RELAXED, __HIP_MEMORY_SCOPE_AGENT); }
__device__ __forceinline__ unsigned xb_xcc_id() { return (unsigned)__builtin_amdgcn_s_getreg((3 << 11) | 20) & 0xFu; }
#define XB_SPIN(cond, bar) do { unsigned _sp = 0; while (cond) { __builtin_amdgcn_s_sleep(1); \
    if ((++_sp & 255u) == 0u) { if (xb_ld(&(bar)[XB_TMO])) break; if (_sp > XB_SPIN_CAP) { atomicAdd(&(bar)[XB_TMO], 1u); break; } } } } while (0)

struct XcdBarrier {
    unsigned* bar; unsigned x;
    volatile LAS unsigned* st;
};

__device__ __forceinline__ XcdBarrier xcd_barrier_post(unsigned* bar, volatile LAS unsigned* st, bool t0) {
    XcdBarrier b; b.bar = bar; b.x = xb_xcc_id(); b.st = st;
    if (t0) (void)xb_add(&bar[XB_XCNT(b.x)], 1u);
    return b;
}
__device__ __forceinline__ void xcd_barrier_complete(unsigned* bar, unsigned x, unsigned& nloc, unsigned& nx) {
    const unsigned G = gridDim.x * gridDim.y * gridDim.z;
    unsigned sum, cnt, mine, sp = 0u;
    for (;;) {
        sum = 0u; cnt = 0u; mine = 0u;
#pragma unroll
        for (unsigned j = 0; j < 16; ++j) { const unsigned c = xb_ld(&bar[XB_XCNT(j)]); sum += c; cnt += (c > 0u) ? 1u : 0u; mine = (j == x) ? c : mine; }
        if (sum == G) break;
        __builtin_amdgcn_s_sleep(1);
        if ((++sp & 255u) == 0u) { if (xb_ld(&bar[XB_TMO])) break; if (sp > XB_SPIN_CAP) { atomicAdd(&bar[XB_TMO], 1u); break; } }
    }
    nloc = mine > 0u ? mine : 1u; nx = cnt > 0u ? cnt : 1u;
}

__device__ __forceinline__ void xcd_census(const XcdBarrier& b) {
    OPAQUE_PTR(unsigned*, bar, b.bar);
    const unsigned G = gridDim.x * gridDim.y * gridDim.z;
    unsigned sum, cnt, mine, msk, sp = 0u;
    for (;;) {
        sum = 0u; cnt = 0u; mine = 0u; msk = 0u;
#pragma unroll 1
        for (unsigned j = 0; j < 16; ++j) { const unsigned c = xb_ld(&bar[256 + 64 * j]); sum += c; cnt += (c > 0u) ? 1u : 0u; msk |= (c > 0u) ? (1u << j) : 0u; mine = (j == b.x) ? c : mine; }
        if (sum == G) break;
        __builtin_amdgcn_s_sleep(1);
        if ((++sp & 255u) == 0u) { if (xb_ld(&bar[XB_TMO])) break; if (sp > XB_SPIN_CAP) { atomicAdd(&bar[XB_TMO], 1u); break; } }
    }
    b.st[0] = mine > 0u ? mine : 1u; b.st[1] = cnt > 0u ? cnt : 1u; b.st[2] = msk | (1u << b.x);
}
__device__ __forceinline__ void xcd_barrier(const XcdBarrier& b, int wid_s) {
    asm volatile("s_waitcnt vmcnt(0)" ::: "memory");
    __syncthreads();
    if (wid_s == 0 && FRESH_TID(0) == 0) {
        OPAQUE_PTR(unsigned*, bar, b.bar);
        __builtin_amdgcn_s_waitcnt(0);
        const unsigned nloc = b.st[0], nx = b.st[1];
        const unsigned old = xb_add(&bar[XB_XSUB(b.x)], 1u);
        const unsigned gen = old / nloc;
        if (old + 1u == (gen + 1u) * nloc) {
            __builtin_amdgcn_fence(__ATOMIC_RELEASE, "agent");
            asm volatile("s_waitcnt vmcnt(0)" ::: "memory");
            const unsigned og = xb_add(&bar[XB_TOP], 1u);
            const unsigned tg = og / nx;
            asm volatile("buffer_inv sc1" ::: "memory");
            if (og + 1u == (tg + 1u) * nx) {
                const unsigned msk = b.st[2];
#pragma unroll 1
                for (unsigned j = 0; j < 16; ++j) if ((msk >> j) & 1u) xb_add(&bar[2304 + 64 * j], 1u);
            } else XB_SPIN(xb_ld(&bar[XB_XGEN(b.x)]) == gen, bar);
            asm volatile("s_waitcnt vmcnt(0)" ::: "memory");
        } else {
            asm volatile("buffer_inv sc1" ::: "memory");
            XB_SPIN(xb_ld(&bar[XB_XGEN(b.x)]) == gen, bar);
            asm volatile("s_waitcnt vmcnt(0)" ::: "memory");
        }
    }
    __syncthreads();
}

constexpr int NPHASES = 26;
__global__ void __launch_bounds__(NTHREADS, 2) mega_fwd(Params P) {
    extern __shared__ __attribute__((aligned(16))) unsigned char lds_raw[];
    ldsp_t lds = (ldsp_t)lds_raw;
    cg::grid_group grid = cg::this_grid();
    const int lo = P.ph_lo, hi = P.ph_hi;
    bool started = false;
    volatile LAS unsigned* bst = (volatile LAS unsigned*)(lds + (LDS_BYTES - 64));
    const int wid_s = __builtin_amdgcn_readfirstlane((int)threadIdx.x >> 6);
    if (wid_s == 0 && FRESH_TID(0) < 2) bst[FRESH_TID(0)] = 0u;
    __syncthreads();
    XcdBarrier xbar = xcd_barrier_post((unsigned*)P.ws, bst, wid_s == 0 && FRESH_TID(0) == 0);
    int nseam = 0;
#define PHASE(id) if (lo <= (id) && (id) < hi)
#define SEAM() do { if (started) { xcd_barrier(xbar, wid_s); ++nseam; } started = true; } while (0)

    PHASE(0) { SEAM(); phase_p0a(P, lds, wid_s); }
    PHASE(1) { if (P.ph_hi < 0) grid.sync();
               if (started && wid_s == 0 && FRESH_TID(0) == 0) xcd_census(xbar);
               SEAM(); phase_p0b(P, lds, wid_s); }

    for (int li = 0; li < 4; ++li) {
        const int pb = 2 + 6 * li;
        PHASE(pb + 0) {
            SEAM();
            {
            OPAQUE_PTR(unsigned char*, ws, P.ws); OPAQUE_PTR(float*, outp, P.out);
            if (li == 0) {
                pg8::Gemm g{(const bf16_t*)(ws + WS_XS), (const bf16_t*)(ws + W_QKVA), MROWS, 3072, 1024}; pg8::StaticOrder S; S.init(MROWS, 3072, gridDim.x, (int)blockIdx.x);
                EpiQKV<0> E{ws, outp, li};
                pg8::gemm_phase<EpiQKV<0>, pg8::StaticOrder, true, true>(lds, g, S, E, wid_s);
            } else if (li == 1 || li == 2) {
                pg8::Gemm g{(const bf16_t*)(ws + WS_XS), (const bf16_t*)(ws + (li == 1 ? W_QKVB : W_QKVC)), MROWS, 1536, 1024};
                EpiQKV<1> E{ws, outp, li};
                if (gridDim.x == 256) {
                    pg8::FirstOrder S1; S1.init(MROWS, 1536, 256, (int)blockIdx.x); pg8::gemm_phase<EpiQKV<1>, pg8::FirstOrder, true, true>(lds, g, S1, E, wid_s);
                    pg8::HalfOrder S2; S2.init(MROWS, 1536, 256, (int)blockIdx.x); pg8::gemm_phase<EpiQKV<1>, pg8::HalfOrder, true, true, 0, true>(lds, g, S2, E, wid_s);
                } else { pg8::StaticOrder S; S.init(MROWS, 1536, gridDim.x, (int)blockIdx.x); pg8::gemm_phase<EpiQKV<1>, pg8::StaticOrder, true, true>(lds, g, S, E, wid_s); }
            } else {
                pg8::Gemm g{(const bf16_t*)(ws + WS_XS), (const bf16_t*)(ws + W_IND), MROWS, 5120, 1024}; pg8::StaticOrder S; S.init(MROWS, 5120, gridDim.x, (int)blockIdx.x);
                EpiInD E{ws};
                pg8::gemm_phase<EpiInD, pg8::StaticOrder, true, true>(lds, g, S, E, wid_s);
            }
            }
        }
        PHASE(pb + 1) {
            SEAM();
            {
            OPAQUE_PTR(unsigned char*, ws, P.ws); OPAQUE_PTR(float*, outp, P.out);
            const float* sv = (const float*)(ws + WS_SMALL);
            int gdx = (int)gridDim.x, bix = (int)blockIdx.x; LAUNDER_S(gdx); LAUNDER_S(bix);
            if (li < 3) {
                AttnArgs A;
                A.Q = (const bf16_t*)(ws + B_Q); A.Kp = (const bf16_t*)(ws + B_K); A.Ks = (const bf16_t*)(ws + B_K + 16 * MiB); A.Vtp = (const bf16_t*)(ws + B_V); A.Vts = (const bf16_t*)(ws + B_V + 16 * MiB);
                A.cK = (const bf16_t*)(ws + (li == 0 ? CTX_KA : (li == 1 ? CTX_KB : CTX_KC))); A.cVt = (const bf16_t*)(ws + (li == 0 ? CTX_VA : (li == 1 ? CTX_VB : CTX_VC)));
                A.O = (bf16_t*)(ws + B_O); A.sink = li == 1 ? sv + SV_SINK : nullptr; A.window = li == 1 ? 1 : 0; A.lam = sv[SV_LAM]; A.osc = sv[SV_OSC]; A.subln = sv + SV_SUBLN;
                const int xcd = bix & 7, idx = bix >> 3, nrd = (gdx == 256) ? 4 : 0;
                if (li == 0) {
                    for (int r = 0; r < nrd; ++r) {
                        if (r < 2) { const int pair = 16 * r + 2 * xcd + (idx >> 4); attn_unit_rs<0>(lds, A, 1, pair >> 3, pair & 7, idx & 15, wid_s); }
                        else { const int pair = 128 * (r - 2) + 16 * xcd + (idx >> 1); attn_unit_rs<0>(lds, A, 0, pair >> 3, pair & 7, idx & 1, wid_s); }
                    }
                    if (nrd == 0) for (int u = bix; u < 1024; u += gdx) {
                        if (u < 512) attn_unit_rs<0>(lds, A, 1, u >> 7, (u >> 4) & 7, u & 15, wid_s);
                        else { const int v = u - 512; attn_unit_rs<0>(lds, A, 0, v >> 4, (v >> 1) & 7, v & 1, wid_s); }
                    }
                } else {
                    for (int r = 0; r < nrd; ++r) {
                        if (r < 2) { const int pair = 8 * r + xcd; attn_unit_rs<1>(lds, A, 1, pair >> 2, pair & 3, idx, wid_s); }
                        else { const int pair = 64 * (r - 2) + 8 * xcd + (idx >> 2); attn_unit_rs<1>(lds, A, 0, pair >> 2, pair & 3, idx & 3, wid_s); }
                    }
                    if (nrd == 0) for (int u = bix; u < 1024; u += gdx) {
                        if (u < 512) attn_unit_rs<1>(lds, A, 1, u >> 7, (u >> 5) & 3, u & 31, wid_s);
                        else { const int v = u - 512; attn_unit_rs<1>(lds, A, 0, v >> 4, (v >> 2) & 3, v & 3, wid_s); }
                    }
                }
            } else {
                GlaArgs A{(const bf16_t*)(ws + B_DQ), (const bf16_t*)(ws + B_DV), (const _Float16*)(ws + B_DLF), (bf16_t*)(ws + WS_XB), (bf16_t*)(ws + B_DOB), P.in[9], outp + OUT_SD};
                GlaRegs R;
                const bool bal = gdx == 256; const int nun = bal ? (bix < 128 ? 2 : 7) : (1152 - bix + gdx - 1) / gdx;
                auto rl7 = [](int u) { const int i_ = (u >> 3) & 15; return (u & ~127) | ((i_ >> 2) << 5) | ((u & 7) << 2) | (((i_ >> 1) & 1) << 1) | (i_ & 1); };
                auto unit_at = [&](int k) { return bal ? rl7(bix < 128 ? (k == 0 ? bix : 1024 + bix) : bix + 128 * k) : bix + k * gdx; };
                gla_fetch(A, R, unit_at(0), 0, FRESH_TID(wid_s));
                for (int k = 0; k < nun; ++k) gla_unit(lds, A, unit_at(k), k + 1 < nun ? unit_at(k + 1) : -1, R, wid_s);
            }
            }
        }
        PHASE(pb + 2) { if (li == 3) { SEAM(); phase_gnorm(P, wid_s); } }
        PHASE(pb + 3) {
            SEAM();
            OPAQUE_PTR(unsigned char*, ws, P.ws); OPAQUE_PTR(float*, outp, P.out);
            pg8::Gemm g{(const bf16_t*)(ws + (li == 3 ? B_DG : B_O)), (const bf16_t*)(ws + W_O) + (size_t)li * 1048576, MROWS, 1024, 1024}; pg8::StaticOrder S; S.init(MROWS, 1024, gridDim.x, (int)blockIdx.x);
            EpiRes E{P.in[0], P.in[1], ws, outp, li, 0};
            pg8::gemm_phase<EpiRes, pg8::StaticOrder, false, true>(lds, g, S, E, wid_s);
        }
        PHASE(pb + 4) {
            SEAM();
            OPAQUE_PTR(unsigned char*, ws, P.ws);
            pg8::Gemm g{(const bf16_t*)(ws + WS_XS), (const bf16_t*)(ws + W_FF1) + (size_t)li * 5632 * 1024, MROWS, 5632, 1024}; pg8::StaticOrder S; S.init(MROWS, 5632, gridDim.x, (int)blockIdx.x);
            stage_epi_rb(lds, S, (const float*)(ws + WS_RSS) + (size_t)(2 * li + 1) * MROWS * 4, (const float*)(ws + WS_BIAS) + (size_t)(2 * li + 1) * 5 * 5632, 5632, wid_s);
            EpiSwiGLU E{ws, li, lds};
            pg8::gemm_phase<EpiSwiGLU, pg8::StaticOrder, true, true>(lds, g, S, E, wid_s);
            int gdc = (int)gridDim.x, bic = (int)blockIdx.x; LAUNDER_S(gdc); LAUNDER_S(bic);
            if (li < 3 && gdc == 256 && bic >= 128) {
                const int tid_c = FRESH_TID(wid_s); const int lane = tid_c & 63, wv = wid_s, gwv = (bic - 128) * 8 + wv;
                LAS float* scr = (LAS float*)(lds + wv * 17408);
                const int nit = layer_items(li + 1);
                for (int it = gwv; it < nit; it += 1024) convert_layer_item(P, ws, li + 1, it, scr, lane);
            }
        }
        PHASE(pb + 5) {
            SEAM();
            OPAQUE_PTR(unsigned char*, ws, P.ws); OPAQUE_PTR(float*, outp, P.out);
            pg8::Gemm g{(const bf16_t*)(ws + B_H), (const bf16_t*)(ws + W_FF2) + (size_t)li * 1024 * 2816, MROWS, 1024, DFF}; pg8::StaticOrder S; S.init(MROWS, 1024, gridDim.x, (int)blockIdx.x);
            EpiRes E{P.in[0], P.in[1], ws, outp, li, 1};
            pg8::gemm_phase<EpiRes, pg8::StaticOrder, false, true, 32>(lds, g, S, E, wid_s);
        }
    }
#undef PHASE
#undef SEAM
}


#ifndef N_LAUNCH_MODE
#define N_LAUNCH_MODE 1
#endif
#ifndef MAX_PHASE
#define MAX_PHASE NPHASES
#endif
extern "C" void kernel_launch(void* const* d_in, const int* in_sizes, int n_in, void* d_out, int out_size, void* d_ws, size_t ws_size, hipStream_t stream) {
    static int grid = 0;
    if (grid == 0) {
        int dev = 0, cus = 0, per_cu = 0;
        (void)hipGetDevice(&dev);
        (void)hipDeviceGetAttribute(&cus, hipDeviceAttributeMultiprocessorCount, dev);
        (void)hipFuncSetAttribute((const void*)mega_fwd, hipFuncAttributeMaxDynamicSharedMemorySize, LDS_BYTES);
        (void)hipOccupancyMaxActiveBlocksPerMultiprocessor(&per_cu, (const void*)mega_fwd, NTHREADS, LDS_BYTES);
        (void)hipGetLastError();
        grid = cus * (per_cu < 1 ? 1 : per_cu);
        if (grid != 256) fprintf(stderr, "kernel_launch: grid %d (cus %d per_cu %d): this kernel is built for 256 resident workgroups\n", grid, cus, per_cu);
        if (n_in != 40 || ws_size < WS_END) fprintf(stderr, "kernel_launch: n_in %d ws %zu (need %zu)\n", n_in, ws_size, (size_t)WS_END);
        if (grid > 256) grid = 256;
    }
    Params p{};
    for (int i = 0; i < 40; ++i) p.in[i] = (const float*)d_in[i];
    p.out = (float*)d_out; p.ws = (unsigned char*)d_ws;
#if N_LAUNCH_MODE == 1
    p.ph_lo = 0; p.ph_hi = NPHASES;
    (void)hipMemsetAsync(d_ws, 0, 16384, stream);
    void* args[] = {&p};
    hipError_t e = hipLaunchCooperativeKernel((const void*)mega_fwd, dim3(grid), dim3(NTHREADS), args, LDS_BYTES, stream);
    if (e != hipSuccess) fprintf(stderr, "cooperative launch failed: %s (grid %d)\n", hipGetErrorString(e), grid);
#else
    for (int ph = 0; ph < MAX_PHASE; ++ph) {
        const int li = ph >= 2 ? (ph - 2) / 6 : -1, sub = ph >= 2 ? (ph - 2) % 6 : -1;
        if (sub == 2 && li != 3) continue;
        p.ph_lo = ph; p.ph_hi = ph + 1;
        hipLaunchKernelGGL(mega_fwd, dim3(grid), dim3(NTHREADS), LDS_BYTES, stream, p);
    }
#endif
}
```
